# Optimizing an MI355X kernel written in HIP

```python
import math
import jax, jax.numpy as jnp
from jax import lax
import numpy as np


D_MODEL = 1024
BATCH = 8
SEQ = 2048
DEPTH = 2

CHUNK = 64
N_MEM = 256
HEAD_DIM = 64
MIX_WIDTH = (D_MODEL * 3) // 4
N_MIX_HEADS = MIX_WIDTH // HEAD_DIM
MEM_WIDTH = D_MODEL - MIX_WIDTH
N_MEM_HEADS = MEM_WIDTH // HEAD_DIM
D_FF = 2816
DECAY_LORA = 64
AAA_LORA = 64
GATE_LORA = 128
Q_BLOCK = 128
N_MIXERS = 2
N_RWKV = (DEPTH + 1) // 2
N_SB = DEPTH // 2
ALPHA = (2 * DEPTH) ** 0.25
BETA = (8 * DEPTH) ** -0.25
LN_EPS = 1e-5
LNX_EPS = 64e-5
RWKV_SHIFT = 3 * MIX_WIDTH + DECAY_LORA + AAA_LORA + GATE_LORA
RWKV_IN = RWKV_SHIFT + MEM_WIDTH
SB_IN = 3 * MIX_WIDTH + MEM_WIDTH

kernel_name = "hybrid_rwkv7_stickbreak_macaron_deepnorm"


def layer_norm(x, g, b):
    xf = x.astype(jnp.float32)
    mu = jnp.mean(xf, axis=-1, keepdims=True)
    var = jnp.mean(jnp.square(xf - mu), axis=-1, keepdims=True)
    return ((xf - mu) * lax.rsqrt(var + LN_EPS) * g + b).astype(x.dtype)


def swiglu(x, w_gate, w_up, w_down):
    return (jax.nn.silu(x @ w_gate) * (x @ w_up)) @ w_down


def split_heads(t):
    b, s, _ = t.shape
    return t.reshape(b, s, -1, HEAD_DIM).transpose(0, 2, 1, 3)


def merge_heads(t):
    b, h, s, d = t.shape
    return t.transpose(0, 2, 1, 3).reshape(b, s, h * d)


def token_shift(p, mu):
    prev = jnp.pad(p, ((0, 0), (1, 0), (0, 0)))[:, :-1]
    return p + (prev - p) * mu


def memory_attention(mq, mem_k, mem_v):
    q = split_heads(mq)
    scores = jnp.einsum('bhsd,bhmd->bhsm', q, mem_k).astype(jnp.float32) / math.sqrt(HEAD_DIM)
    p = jax.nn.softmax(scores, axis=-1).astype(mq.dtype)
    return merge_heads(jnp.einsum('bhsm,bhmd->bhsd', p, mem_v))


def rwkv7_mix(z_in, mu, w0, w_up, a0, a_up, g_up, k_k, k_a, r_k, lnx_g, lnx_b):
    bsz, seq, _ = z_in.shape
    dt = z_in.dtype
    z = token_shift(z_in, mu)
    c = MIX_WIDTH
    r = z[..., :c]
    k = z[..., c:2 * c]
    v = z[..., 2 * c:3 * c]
    o = 3 * c
    dw = z[..., o:o + DECAY_LORA]
    o += DECAY_LORA
    da = z[..., o:o + AAA_LORA]
    o += AAA_LORA
    dg = z[..., o:o + GATE_LORA]
    w = -jax.nn.softplus(-(w0 + jnp.tanh(dw) @ w_up)) - 0.5
    a = jax.nn.sigmoid(a0 + da @ a_up)
    g = jax.nn.sigmoid(dg) @ g_up

    def hs(t):
        return t.astype(jnp.float32).reshape(bsz, seq, N_MIX_HEADS, HEAD_DIM)

    kk = hs(k * k_k)
    kk = kk * lax.rsqrt(jnp.maximum(jnp.sum(kk * kk, axis=-1, keepdims=True), 1e-24))
    k = hs(k * (1.0 + (a - 1.0) * k_a))
    r, v, a = hs(r), hs(v), hs(a)
    decay = jnp.exp(-jnp.exp(hs(w)))

    n_chunks = seq // CHUNK

    def to_chunks(t):
        return t.transpose(1, 0, 2, 3).reshape(n_chunks, CHUNK, bsz, N_MIX_HEADS, HEAD_DIM)

    xs = (to_chunks(r), to_chunks(decay), to_chunks(k), to_chunks(v), to_chunks(kk), to_chunks(kk * a))

    def step(state, inp):
        r_t, w_t, k_t, v_t, kk_t, b_t = inp
        sa = jnp.einsum('bhij,bhj->bhi', state, kk_t)
        state = (state * w_t[:, :, None, :] - sa[..., :, None] * b_t[..., None, :]
                 + v_t[..., :, None] * k_t[..., None, :])
        return state, jnp.einsum('bhij,bhj->bhi', state, r_t)

    def chunk_step(state, chunk_inp):
        return lax.scan(step, state, chunk_inp)

    state0 = jnp.zeros((bsz, N_MIX_HEADS, HEAD_DIM, HEAD_DIM), jnp.float32)
    _, out = lax.scan(chunk_step, state0, xs)
    out = out.reshape(seq, bsz, N_MIX_HEADS, HEAD_DIM).transpose(1, 0, 2, 3)
    m = jnp.mean(out, axis=-1, keepdims=True)
    var = jnp.mean(jnp.square(out - m), axis=-1, keepdims=True)
    out = ((out - m) * lax.rsqrt(var + LNX_EPS)).reshape(bsz, seq, c) * lnx_g + lnx_b
    bonus = jnp.sum(r * k * r_k, axis=-1, keepdims=True) * v
    y = (out + bonus.reshape(bsz, seq, c)) * g
    return y.astype(dt)


def stick_breaking_mix(q, k, v):
    q, k, v = split_heads(q), split_heads(k), split_heads(v)
    seq = q.shape[2]
    scale = 1.0 / math.sqrt(HEAD_DIM)
    outs = []
    for blk in range(seq // Q_BLOCK):
        start = blk * Q_BLOCK
        end = start + Q_BLOCK
        kb = k[:, :, :end]
        vb = v[:, :, :end]
        z = jnp.einsum('bhtd,bhsd->bhts', q[:, :, start:end], kb).astype(jnp.float32) * scale
        t_pos = start + jnp.arange(Q_BLOCK)[:, None]
        s_pos = jnp.arange(end)[None, :]
        before = s_pos < t_pos
        log_keep = jnp.where(before, -jax.nn.softplus(z), 0.0)
        later = lax.cumsum(log_keep, axis=3, reverse=True) - log_keep
        att = jnp.where(before, jnp.exp(jax.nn.log_sigmoid(z) + later), 0.0)
        outs.append(jnp.einsum('bhts,bhsd->bhtd', att.astype(v.dtype), vb))
    return merge_heads(jnp.concatenate(outs, axis=2))


def setup_inputs(seed: int = 0) -> dict:
    key = jax.random.key(seed)
    ks = jax.random.split(key, 32)
    f32 = jnp.float32
    d, f, c = D_MODEL, D_FF, MIX_WIDTH

    def nrm(k, shape, scale):
        return jax.random.normal(k, shape, f32) * scale

    return {
        "x": nrm(ks[0], (BATCH, SEQ, d), 1.0),
        "mem": nrm(ks[1], (BATCH, N_MEM, d), 1.0),
        "ffn1_w_gate": nrm(ks[2], (DEPTH, d, f), d ** -0.5),
        "ffn1_w_up": nrm(ks[3], (DEPTH, d, f), d ** -0.5),
        "ffn1_w_down": nrm(ks[4], (DEPTH, f, d), BETA * f ** -0.5),
        "ffn2_w_gate": nrm(ks[5], (DEPTH, d, f), d ** -0.5),
        "ffn2_w_up": nrm(ks[6], (DEPTH, d, f), d ** -0.5),
        "ffn2_w_down": nrm(ks[7], (DEPTH, f, d), BETA * f ** -0.5),
        "ln_g": 1.0 + nrm(ks[8], (DEPTH, 3, d), 0.02),
        "ln_b": nrm(ks[9], (DEPTH, 3, d), 0.02),
        "w_out": nrm(ks[10], (DEPTH, d, d), BETA * d ** -0.5),
        "w_mem_kv": nrm(ks[11], (d, 2 * MEM_WIDTH), d ** -0.5),
        "rwkv_w_in": nrm(ks[12], (N_RWKV, d, RWKV_IN), d ** -0.5),
        "rwkv_mu": jax.random.uniform(ks[13], (N_RWKV, RWKV_SHIFT), f32),
        "rwkv_w0": jax.random.uniform(ks[14], (N_RWKV, c), f32, -6.0, -1.0),
        "rwkv_w_up": nrm(ks[15], (N_RWKV, DECAY_LORA, c), 0.1 * DECAY_LORA ** -0.5),
        "rwkv_a0": nrm(ks[16], (N_RWKV, c), 0.5),
        "rwkv_a_up": nrm(ks[17], (N_RWKV, AAA_LORA, c), 0.5 * AAA_LORA ** -0.5),
        "rwkv_g_up": nrm(ks[18], (N_RWKV, GATE_LORA, c), GATE_LORA ** -0.5),
        "rwkv_k_k": 1.0 + nrm(ks[19], (N_RWKV, c), 0.1),
        "rwkv_k_a": 1.0 + nrm(ks[20], (N_RWKV, c), 0.1),
        "rwkv_r_k": nrm(ks[21], (N_RWKV, N_MIX_HEADS, HEAD_DIM), 0.1),
        "rwkv_lnx_g": 1.0 + nrm(ks[22], (N_RWKV, c), 0.02),
        "rwkv_lnx_b": nrm(ks[23], (N_RWKV, c), 0.02),
        "sb_w_in": nrm(ks[24], (N_SB, d, SB_IN), d ** -0.5),
    }


def reference(x, mem, ffn1_w_gate, ffn1_w_up, ffn1_w_down, ffn2_w_gate, ffn2_w_up, ffn2_w_down,
              ln_g, ln_b, w_out, w_mem_kv, rwkv_w_in, rwkv_mu, rwkv_w0, rwkv_w_up, rwkv_a0,
              rwkv_a_up, rwkv_g_up, rwkv_k_k, rwkv_k_a, rwkv_r_k, rwkv_lnx_g, rwkv_lnx_b, sb_w_in):
    mem_kv = mem @ w_mem_kv
    mem_k = split_heads(mem_kv[..., :MEM_WIDTH])
    mem_v = split_heads(mem_kv[..., MEM_WIDTH:])
    c = MIX_WIDTH
    for i in range(DEPTH):
        x = layer_norm(ALPHA * x + 0.5 * swiglu(x, ffn1_w_gate[i], ffn1_w_up[i], ffn1_w_down[i]),
                       ln_g[i, 0], ln_b[i, 0])
        j = i // N_MIXERS
        if i % N_MIXERS == 0:
            proj = x @ rwkv_w_in[j]
            mix = rwkv7_mix(proj[..., :RWKV_SHIFT], rwkv_mu[j], rwkv_w0[j], rwkv_w_up[j],
                            rwkv_a0[j], rwkv_a_up[j], rwkv_g_up[j], rwkv_k_k[j], rwkv_k_a[j],
                            rwkv_r_k[j], rwkv_lnx_g[j], rwkv_lnx_b[j])
            mq = proj[..., RWKV_SHIFT:]
        else:
            proj = x @ sb_w_in[j]
            mix = stick_breaking_mix(proj[..., :c], proj[..., c:2 * c], proj[..., 2 * c:3 * c])
            mq = proj[..., 3 * c:]
        heads = jnp.concatenate([mix, memory_attention(mq, mem_k, mem_v)], axis=-1)
        x = layer_norm(ALPHA * x + heads @ w_out[i], ln_g[i, 1], ln_b[i, 1])
        x = layer_norm(ALPHA * x + 0.5 * swiglu(x, ffn2_w_gate[i], ffn2_w_up[i], ffn2_w_down[i]),
                       ln_g[i, 2], ln_b[i, 2])
    return x
```

```cpp
#include <hip/hip_runtime.h>
#include <hip/hip_cooperative_groups.h>
#include <cstdio>
#include <cstdint>
namespace cg = cooperative_groups;
namespace pg8 {
#define PG8_LAS __attribute__((address_space(3)))
typedef unsigned short bf16_t;
typedef short bf16x8 __attribute__((ext_vector_type(8)));
typedef float f32x4 __attribute__((ext_vector_type(4)));
typedef unsigned u32x4 __attribute__((ext_vector_type(4)));
constexpr int BM = 256, BK = 64, HALF = 128, HTB = HALF * BK * 2  , STAGE_BYTES = 8 * HTB, NXCD = 8, WGM = 8;

__host__ __device__ __forceinline__ int lds_byte(int r, int c) { const int st = (r >> 4) * 2 + (c >> 5), rr = r & 15, cc = c & 31, ob = rr * 64 + cc * 2; return st * 1024 + (ob ^ (((ob >> 9) & 1) << 5)); }
__host__ __device__ __forceinline__ void stage_rc(int b, int& R, int& C) { const int st = b / 1024, sb = b % 1024, swz = sb ^ (((sb >> 9) & 1) << 5); R = (st >> 1) * 16 + swz / 64; C = (st & 1) * 32 + (swz % 64) / 2; }
__host__ __device__ __forceinline__ int perm32(int rho) { const int n = rho >> 4, i = rho & 15; return 8 * (i >> 2) + 4 * n + (i & 3); }

struct Unit { int pm, pn; };
struct Gemm { const bf16_t* A; const bf16_t* Bt; int M, N, K; };

struct StaticOrder {
    int nM, nN, nwg, G, c;
    __host__ __device__ void init(int M, int N, int G_, int c_) { nM = M / BM; nN = N / BM; nwg = nM * nN; G = G_; c = c_; }
    __host__ __device__ bool next(int i, Unit& u) const {
        const long L = (long)i * G + c; if (L >= nwg) return false;
        int wgid = (int)L; { const int q = nwg / NXCD, r = nwg % NXCD, xcd = wgid % NXCD, off = wgid / NXCD; wgid = (xcd < r ? xcd * (q + 1) : r * (q + 1) + (xcd - r) * q) + off; }
        const int nig = WGM * nN, gid = wgid / nig, fm = gid * WGM, gsz = (nM - fm) < WGM ? (nM - fm) : WGM;
        u.pm = fm + ((wgid % nig) % gsz); u.pn = (wgid % nig) / gsz; return true;
    }
    __device__ __forceinline__ void a_ready(const Unit&) const {}
    __device__ __forceinline__ void done(const Unit&) const {}
};

__device__ __forceinline__ unsigned cvt_pk_bf16(float lo, float hi) { unsigned r; asm volatile("v_cvt_pk_bf16_f32 %0, %1, %2" : "=v"(r) : "v"(lo), "v"(hi)); return r; }
typedef float f32x2 __attribute__((ext_vector_type(2)));
__device__ __forceinline__ f32x2 gelu_pk(f32x2 v) {
    const f32x2 av = __builtin_elementwise_abs(v), d = av * 0.2316418882f + 1.0f;
    f32x2 t; t.x = __builtin_amdgcn_rcpf(d.x); t.y = __builtin_amdgcn_rcpf(d.y);
    f32x2 q = t * 0.5307027145f + (-0.7265760135f); q = q * t + 0.7107068705f; q = q * t + (-0.142248368f); q = q * t + 0.127414796f; q = q * t;
    const f32x2 s = (v * v) * (-0.72134752044f);
    f32x2 e; e.x = __builtin_amdgcn_exp2f(s.x); e.y = __builtin_amdgcn_exp2f(s.y);
    const f32x2 m = v * (q * e), r = v - m;
    f32x2 o; o.x = v.x < 0.f ? m.x : r.x; o.y = v.y < 0.f ? m.y : r.y; return o;
}

template <int ACT  > struct EpiBf16 {
    static constexpr bool PERM = true, AFTER_DRAIN = false; static_assert(ACT == 0 || ACT == 1, "EpiBf16: ACT is 0 (none) or 1 (gelu_pk)");
    bf16_t* O; int ldc; const float* bias; int split_cols; size_t split_stride; float scale0;
    __device__ __forceinline__ void operator()(const f32x4 (&acc)[2][2][4][2], const Unit& u, int wr, int wc, int fr, int fq) const {
        const int row0 = u.pm * BM + wr * 64 + fr; int colt = u.pn * BM; bf16_t* base = O;
        float sc = 1.f; if (split_cols) { const int t = colt / split_cols; base += (size_t)t * split_stride; colt -= t * split_cols; if (t == 0) sc = scale0; }
        const int col0 = colt + wc * 32 + 8 * fq, bcol0 = u.pn * BM + wc * 32 + 8 * fq;
        f32x4 bv[2][2];
#pragma unroll
        for (int bj = 0; bj < 2; ++bj)
#pragma unroll
            for (int n = 0; n < 2; ++n) bv[bj][n] = bias ? *(const f32x4*)(bias + bcol0 + bj * HALF + 4 * n) : (f32x4){0.f, 0.f, 0.f, 0.f};
#pragma unroll
        for (int ai = 0; ai < 2; ++ai)
#pragma unroll
            for (int m = 0; m < 4; ++m) { bf16_t* rowp = base + (size_t)(row0 + ai * HALF + m * 16) * ldc + col0;
#pragma unroll
                for (int bj = 0; bj < 2; ++bj) { f32x4 v0 = acc[ai][bj][m][0] + bv[bj][0], v1 = acc[ai][bj][m][1] + bv[bj][1];
                    if (ACT == 1) { f32x2 a = gelu_pk((f32x2){v0[0], v0[1]}), b = gelu_pk((f32x2){v0[2], v0[3]}), c = gelu_pk((f32x2){v1[0], v1[1]}), d = gelu_pk((f32x2){v1[2], v1[3]});
                        v0 = (f32x4){a.x, a.y, b.x, b.y}; v1 = (f32x4){c.x, c.y, d.x, d.y}; }
                    v0 = v0 * sc; v1 = v1 * sc; u32x4 w; w.x = cvt_pk_bf16(v0[0], v0[1]); w.y = cvt_pk_bf16(v0[2], v0[3]); w.z = cvt_pk_bf16(v1[0], v1[1]); w.w = cvt_pk_bf16(v1[2], v1[3]);
                    *(u32x4*)(rowp + bj * HALF) = w; } }
    }
};

template <class Epi, class Sched, bool ALIGN_EPI = false, bool SP2 = false>
__device__ __forceinline__ void gemm_phase(PG8_LAS unsigned char* lds, const Gemm g, const Sched& S, const Epi& E) {
    int tid_l = threadIdx.x; asm volatile("" : "+v"(tid_l));
    const int tid = tid_l, wid = __builtin_amdgcn_readfirstlane(tid >> 6), lane = tid & 63, wr = wid >> 2, wc = wid & 3, fr = lane & 15, fq = lane >> 4;
    const int K = g.K, nt = K / BK;
    unsigned voffA[2], voffB[2];
#pragma unroll
    for (int i = 0; i < 2; ++i) { int R, C; stage_rc(tid * 16 + i * 8192, R, C); const int Rb = Epi::PERM ? ((R & ~31) + perm32(R & 31)) : R;
        voffA[i] = (unsigned)(R * K + C) * 2u; voffB[i] = (unsigned)(Rb * K + C) * 2u; }
    const size_t kstep = (size_t)(BK * 2);
    const size_t hstep = (size_t)HALF * K * 2;
    const size_t tstep = 2 * hstep;
    const unsigned ldsw = (unsigned)wid * 1024u;
    const int aoff = lds_byte(wr * 64 + fr, fq * 8), boff = lds_byte(wc * 32 + fr, fq * 8);
#define PG8_SA(b, h) (((b) * 2 + (h)) * HTB)
#define PG8_SB(b, h) ((4 + (b) * 2 + (h)) * HTB)
#define PG8_STAGE(bufoff, gbase, voff) do { _Pragma("unroll") for (int _i = 0; _i < 2; ++_i) \
        __builtin_amdgcn_global_load_lds((const unsigned*)((const char*)(gbase) + (voff)[_i]), (PG8_LAS unsigned*)(lds + (bufoff) + ldsw + _i * 8192), 16, 0, 0); } while (0)
#define PG8_LDA(dst, b, h) do { _Pragma("unroll") for (int m = 0; m < 4; ++m) _Pragma("unroll") for (int k = 0; k < 2; ++k) dst[m][k] = *(const PG8_LAS bf16x8*)(lds + PG8_SA(b, h) + aoff + m * 2048 + k * 1024); } while (0)
#define PG8_LDB(dst, b, h) do { _Pragma("unroll") for (int n = 0; n < 2; ++n) _Pragma("unroll") for (int k = 0; k < 2; ++k) dst[n][k] = *(const PG8_LAS bf16x8*)(lds + PG8_SB(b, h) + boff + n * 2048 + k * 1024); } while (0)
#define PG8_MMA(ai, bj, At, Bt) do { __builtin_amdgcn_s_setprio(1); _Pragma("unroll") for (int m = 0; m < 4; ++m) _Pragma("unroll") for (int n = 0; n < 2; ++n) _Pragma("unroll") for (int k = 0; k < 2; ++k) \
        acc[ai][bj][m][n] = __builtin_amdgcn_mfma_f32_16x16x32_bf16(Bt[n][k], At[m][k], acc[ai][bj][m][n], 0, 0, 0); __builtin_amdgcn_s_setprio(0); } while (0)
#define PG8_WAIT_V(n) asm volatile("s_waitcnt vmcnt(" #n ")" ::: "memory")
#define PG8_WAIT_L(n) asm volatile("s_waitcnt lgkmcnt(" #n ")" ::: "memory")
#define PG8_BAR __builtin_amdgcn_s_barrier()
#define PG8_SCHED __builtin_amdgcn_sched_barrier(0)
    Unit cur, nxt; int ui = 0;
    if (!S.next(0, cur)) return;
    f32x4 acc[2][2][4][2];
#pragma unroll
    for (int a = 0; a < 2; ++a)
#pragma unroll
        for (int b = 0; b < 2; ++b)
#pragma unroll
            for (int m = 0; m < 4; ++m)
#pragma unroll
                for (int n = 0; n < 2; ++n) acc[a][b][m][n] = (f32x4){0.f, 0.f, 0.f, 0.f};
    bf16x8 At[4][2], B0[2][2], B1[2][2];
    const char* cA = (const char*)g.A + (size_t)cur.pm * tstep; const char* cB = (const char*)g.Bt + (size_t)cur.pn * tstep;
    S.a_ready(cur);
    if constexpr (SP2) {
        PG8_STAGE(PG8_SB(0, 0), cB, voffB); PG8_STAGE(PG8_SB(0, 1), cB + hstep, voffB); PG8_STAGE(PG8_SA(0, 0), cA, voffA); PG8_STAGE(PG8_SA(0, 1), cA + hstep, voffA);
        if (wr == 1) PG8_BAR;
        PG8_WAIT_V(2); PG8_BAR;
        PG8_STAGE(PG8_SB(1, 0), cB + kstep, voffB); PG8_STAGE(PG8_SA(1, 0), cA + kstep, voffA); PG8_STAGE(PG8_SB(1, 1), cB + hstep + kstep, voffB);
        PG8_WAIT_V(6); PG8_BAR;
    } else {
        PG8_STAGE(PG8_SB(0, 0), cB, voffB); PG8_STAGE(PG8_SA(0, 0), cA, voffA); PG8_STAGE(PG8_SB(0, 1), cB + hstep, voffB); PG8_STAGE(PG8_SA(0, 1), cA + hstep, voffA);
        if (wr == 1) PG8_BAR;
        PG8_WAIT_V(4); PG8_BAR;
        PG8_STAGE(PG8_SB(1, 0), cB + kstep, voffB); PG8_STAGE(PG8_SA(1, 0), cA + kstep, voffA); PG8_STAGE(PG8_SB(1, 1), cB + hstep + kstep, voffB);
        PG8_WAIT_V(6); PG8_BAR;
    }
    for (;;) {
        const bool has_next = S.next(ui + 1, nxt);
        const char* nA = has_next ? (const char*)g.A + (size_t)nxt.pm * tstep : cA; const char* nB = has_next ? (const char*)g.Bt + (size_t)nxt.pn * tstep : cB;
        for (int t = 0; t < nt; t += 2) {
            const bool last = (t == nt - 2);
            const char* a1 = cA + (size_t)(t + 1) * kstep;
            const char* a2 = last ? nA : cA + (size_t)(t + 2) * kstep; const char* b2 = last ? nB : cB + (size_t)(t + 2) * kstep;
            const char* a3 = a2 + kstep; const char* b3 = b2 + kstep;
            if (last && has_next) S.a_ready(nxt);
            if constexpr (SP2) {
            PG8_LDB(B0, 0, 0); PG8_LDB(B1, 0, 1); PG8_SCHED; PG8_LDA(At, 0, 0); PG8_STAGE(PG8_SA(1, 1), a1 + hstep, voffA);
            PG8_WAIT_V(8); PG8_WAIT_L(0); PG8_BAR; PG8_MMA(0, 0, At, B0); PG8_MMA(0, 1, At, B1); PG8_BAR; PG8_SCHED;
            PG8_LDA(At, 0, 1); PG8_STAGE(PG8_SB(0, 0), b2, voffB); PG8_STAGE(PG8_SB(0, 1), b2 + hstep, voffB); PG8_STAGE(PG8_SA(0, 0), a2, voffA);
            PG8_WAIT_V(8); PG8_WAIT_L(0); PG8_BAR; PG8_MMA(1, 0, At, B0); PG8_MMA(1, 1, At, B1); PG8_BAR; PG8_SCHED;
            PG8_LDB(B0, 1, 0); PG8_LDB(B1, 1, 1); PG8_SCHED; PG8_LDA(At, 1, 0); PG8_STAGE(PG8_SA(0, 1), a2 + hstep, voffA);
            PG8_WAIT_V(8); PG8_WAIT_L(0); PG8_BAR; PG8_MMA(0, 0, At, B0); PG8_MMA(0, 1, At, B1); PG8_BAR; PG8_SCHED;
            PG8_LDA(At, 1, 1); PG8_STAGE(PG8_SB(1, 0), b3, voffB); PG8_STAGE(PG8_SB(1, 1), b3 + hstep, voffB); PG8_STAGE(PG8_SA(1, 0), a3, voffA);
            PG8_WAIT_V(8); PG8_WAIT_L(0); PG8_BAR; PG8_MMA(1, 0, At, B0); PG8_MMA(1, 1, At, B1); PG8_BAR; PG8_SCHED;
            } else {
            PG8_LDB(B0, 0, 0); PG8_SCHED; PG8_LDA(At, 0, 0); PG8_STAGE(PG8_SA(1, 1), a1 + hstep, voffA);
            PG8_WAIT_L(8); PG8_BAR; PG8_WAIT_L(0); PG8_MMA(0, 0, At, B0); PG8_BAR; PG8_SCHED;
            PG8_LDB(B1, 0, 1); PG8_STAGE(PG8_SB(0, 0), b2, voffB);
            PG8_BAR; PG8_WAIT_L(0); PG8_MMA(0, 1, At, B1); PG8_BAR;
            PG8_LDA(At, 0, 1); PG8_STAGE(PG8_SA(0, 0), a2, voffA);
            PG8_BAR; PG8_WAIT_L(0); PG8_MMA(1, 0, At, B0); PG8_BAR; PG8_SCHED;
            PG8_STAGE(PG8_SB(0, 1), b2 + hstep, voffB);
            PG8_WAIT_V(6); PG8_BAR; PG8_MMA(1, 1, At, B1); PG8_BAR;
            PG8_LDB(B0, 1, 0); PG8_SCHED; PG8_LDA(At, 1, 0); PG8_STAGE(PG8_SA(0, 1), a2 + hstep, voffA);
            PG8_WAIT_L(8); PG8_BAR; PG8_WAIT_L(0); PG8_MMA(0, 0, At, B0); PG8_BAR; PG8_SCHED;
            PG8_LDB(B1, 1, 1); PG8_STAGE(PG8_SB(1, 0), b3, voffB);
            PG8_BAR; PG8_WAIT_L(0); PG8_MMA(0, 1, At, B1); PG8_BAR;
            PG8_LDA(At, 1, 1); PG8_STAGE(PG8_SA(1, 0), a3, voffA);
            PG8_BAR; PG8_WAIT_L(0); PG8_MMA(1, 0, At, B0); PG8_BAR; PG8_SCHED;
            PG8_STAGE(PG8_SB(1, 1), b3 + hstep, voffB);
            PG8_WAIT_V(6); PG8_BAR; PG8_MMA(1, 1, At, B1); PG8_BAR;
            }
        }
        if constexpr (ALIGN_EPI) { if (wr == 0) PG8_BAR; }
        if constexpr (!Epi::AFTER_DRAIN) { E(acc, cur, wr, wc, fr, fq); S.done(cur); }
        if (!has_next) break;
#pragma unroll
        for (int a = 0; a < 2; ++a)
#pragma unroll
            for (int b = 0; b < 2; ++b)
#pragma unroll
                for (int m = 0; m < 4; ++m)
#pragma unroll
                    for (int n = 0; n < 2; ++n) acc[a][b][m][n] = (f32x4){0.f, 0.f, 0.f, 0.f};
        cur = nxt; cA = nA; cB = nB; ++ui;
        if constexpr (ALIGN_EPI) { if (wr == 1) PG8_BAR; }
    }
    PG8_WAIT_V(0);
    if constexpr (!ALIGN_EPI) { if (wr == 0) PG8_BAR; }
    PG8_BAR;
    if constexpr (Epi::AFTER_DRAIN) { E.fused(acc, cur, wr, wc, fr, fq, lds, wid, lane); S.done(cur); }
#undef PG8_SA
#undef PG8_SB
#undef PG8_STAGE
#undef PG8_LDA
#undef PG8_LDB
#undef PG8_MMA
#undef PG8_WAIT_V
#undef PG8_WAIT_L
#undef PG8_BAR
#undef PG8_SCHED
}
}

constexpr int D = 1024, NB = 8, SEQ = 2048, M = NB * SEQ, NMEM = 256;
constexpr int C = 768, NH = 12, FF = 2816;
constexpr int RW_SHIFT = 2560, RW_IN = 2816, SB_IN = 2560;
constexpr float ALPHA = 1.41421356237309515f;
constexpr float LN_EPS = 1e-5f, LNX_EPS = 64e-5f;
constexpr int NWAVES = 8, NT = 512;
constexpr int LDS_BYTES = 159744;

#define LAS __attribute__((address_space(3)))
typedef unsigned short bf16;
typedef float f32x4 __attribute__((ext_vector_type(4)));
typedef float f32x16 __attribute__((ext_vector_type(16)));
typedef short bf16x8 __attribute__((ext_vector_type(8)));
typedef unsigned u32x4 __attribute__((ext_vector_type(4)));
typedef unsigned u32x2 __attribute__((ext_vector_type(2)));

constexpr size_t MiB = 1u << 20;
constexpr size_t WS_WGU = 1 * MiB;
constexpr size_t WS_WD = 45 * MiB;
constexpr size_t WS_WIN0 = 67 * MiB;
constexpr size_t WS_WIN1 = WS_WIN0 + (size_t)RW_IN * D * 2;
constexpr size_t WS_WOUT = WS_WIN1 + (size_t)SB_IN * D * 2;
constexpr size_t WS_WMKV = WS_WOUT + 2 * (size_t)D * D * 2;
constexpr size_t WS_LW = WS_WMKV + (size_t)512 * D * 2;
constexpr size_t WS_MEMB = 83 * MiB;
constexpr size_t WS_MEMKV = 87 * MiB;
constexpr size_t WS_XB = 89 * MiB;
constexpr size_t WS_HP = 121 * MiB;
constexpr size_t WS_HEADS = 209 * MiB;
constexpr size_t WS_END = 241 * MiB;
static_assert(WS_LW + (size_t)768 * 256 * 2 <= WS_MEMB, "ws map");

__device__ __forceinline__ unsigned f2bf(float f) { unsigned u = __builtin_bit_cast(unsigned, f); return (u + 0x7fffu + ((u >> 16) & 1u)) >> 16; }
__device__ __forceinline__ unsigned pk2(float lo, float hi) { return f2bf(lo) | (f2bf(hi) << 16); }
__device__ __forceinline__ float bf2f(unsigned short b) { return __builtin_bit_cast(float, (unsigned)b << 16); }
__device__ __forceinline__ float wave_sum(float v) {
#pragma unroll
    for (int o = 1; o < 64; o <<= 1) v += __shfl_xor(v, o);
    return v;
}
__device__ __forceinline__ float wave_max(float v) {
#pragma unroll
    for (int o = 1; o < 64; o <<= 1) v = fmaxf(v, __shfl_xor(v, o));
    return v;
}
__device__ __forceinline__ float sigmoidf_(float x) { return 1.f / (1.f + __expf(-x)); }
__device__ __forceinline__ float softplusf_(float x) { return fmaxf(x, 0.f) + log1pf(expf(-fabsf(x))); }
template <int CTRL> __device__ __forceinline__ float dpp_f(float x) { return __builtin_bit_cast(float, __builtin_amdgcn_update_dpp(0, __builtin_bit_cast(int, x), CTRL, 0xf, 0xf, false)); }
__device__ __forceinline__ float rowsum16(float x) { x += dpp_f<0x128>(x); x += dpp_f<0x124>(x); x += dpp_f<0x122>(x); x += dpp_f<0x121>(x); return x; }

namespace pg8 {
struct EpiSwiglu {
    static constexpr bool PERM = true, AFTER_DRAIN = false;
    bf16_t* H; int ldh;
    __device__ __forceinline__ void operator()(const f32x4 (&acc)[2][2][4][2], const Unit& u, int wr, int wc, int fr, int fq) const {
        const int row0 = u.pm * BM + wr * 64 + fr, col0 = u.pn * HALF + wc * 32 + 8 * fq;
#pragma unroll
        for (int ai = 0; ai < 2; ++ai)
#pragma unroll
            for (int m = 0; m < 4; ++m) {
                float hv[8];
#pragma unroll
                for (int n = 0; n < 2; ++n)
#pragma unroll
                    for (int j = 0; j < 4; ++j) { const float g = acc[ai][0][m][n][j], up = acc[ai][1][m][n][j];
                        hv[n * 4 + j] = g * __builtin_amdgcn_rcpf(1.0f + __builtin_amdgcn_exp2f(-1.4426950408889634f * g)) * up; }
                u32x4 w; w.x = cvt_pk_bf16(hv[0], hv[1]); w.y = cvt_pk_bf16(hv[2], hv[3]); w.z = cvt_pk_bf16(hv[4], hv[5]); w.w = cvt_pk_bf16(hv[6], hv[7]);
                *(u32x4*)(H + (size_t)(row0 + ai * HALF + m * 16) * ldh + col0) = w;
            }
    }
};
struct EpiRes {
    static constexpr bool PERM = false, AFTER_DRAIN = false;
    float* X; float ra, s;
    __device__ __forceinline__ void operator()(const f32x4 (&acc)[2][2][4][2], const Unit& u, int wr, int wc, int fr, int fq) const {
        const int row0 = u.pm * BM + wr * 64 + fr, col0 = u.pn * BM + wc * 32 + 4 * fq;
#pragma unroll
        for (int ai = 0; ai < 2; ++ai)
#pragma unroll
            for (int m = 0; m < 4; ++m) { float* rowp = X + (size_t)(row0 + ai * HALF + m * 16) * 1024 + col0;
#pragma unroll
                for (int bj = 0; bj < 2; ++bj)
#pragma unroll
                    for (int n = 0; n < 2; ++n) { f32x4* p = (f32x4*)(rowp + bj * HALF + n * 16); const f32x4 v = *p; *p = v * ra + acc[ai][bj][m][n] * s; } }
    }
};
}

struct TDesc { const float* src; bf16* dst; int K, N, mode, first; };
constexpr int NDESC = 24;
struct Args {
    const float* x; const float* mem; const float* ln_g; const float* ln_b;
    const float *mu, *w0, *a0, *k_k, *k_a, *r_k, *lnx_g, *lnx_b;
    float* out; unsigned char* ws;
    TDesc td[NDESC]; int nitems; int ph_lo, ph_hi, pad;
};

__device__ __forceinline__ void p0_transpose_item(const float* W, int K, int N, bf16* WT, int mode, LAS float* scr, int item, int lane) {
    const int nblk = N / 32, kb = item / nblk, nb = item % nblk, k0 = 64 * kb, n0 = 32 * nb;
#pragma unroll 8
    for (int i = 0; i < 32; ++i) { const int kk = 2 * i + (lane >> 5); scr[kk * 33 + (lane & 31)] = W[(size_t)(k0 + kk) * N + n0 + (lane & 31)]; }
    asm volatile("s_waitcnt lgkmcnt(0)" ::: "memory");
    const int c = lane & 7;
    const int rbase = mode == 0 ? n0 : (256 * (n0 >> 7) + (n0 & 127) + (mode == 2 ? 128 : 0));
#pragma unroll
    for (int j = 0; j < 4; ++j) { const int n = (lane >> 3) + 8 * j; const LAS float* s = scr + (8 * c) * 33 + n;
        u32x4 o; o.x = pk2(s[0 * 33], s[1 * 33]); o.y = pk2(s[2 * 33], s[3 * 33]); o.z = pk2(s[4 * 33], s[5 * 33]); o.w = pk2(s[6 * 33], s[7 * 33]);
        *(u32x4*)(WT + (size_t)(rbase + n) * K + k0 + 8 * c) = o; }
    asm volatile("s_waitcnt lgkmcnt(0)" ::: "memory");
}
__device__ __forceinline__ void p0_prologue(const Args& a, LAS unsigned char* lds, int gw, int ngw, int wave, int lane) {
    LAS float* scr = (LAS float*)(lds + wave * 16384);
    for (int it = gw; it < a.nitems; it += ngw) {
        int d = 0;
#pragma unroll 1
        for (int j = 1; j < NDESC; ++j) if (it >= a.td[j].first) d = j;
        p0_transpose_item(a.td[d].src, a.td[d].K, a.td[d].N, a.td[d].dst, a.td[d].mode, scr, it - a.td[d].first, lane);
    }
    bf16* xb = (bf16*)(a.ws + WS_XB); bf16* memb = (bf16*)(a.ws + WS_MEMB);
    for (int r = gw; r < M + NB * NMEM; r += ngw) {
        const bool isx = r < M; const int rr = isx ? r : r - M;
        const f32x4* s = (const f32x4*)((isx ? a.x : a.mem) + (size_t)rr * D) + lane;
        u32x2* o = (u32x2*)((isx ? xb : memb) + (size_t)rr * D) + lane;
#pragma unroll
        for (int j = 0; j < 4; ++j) { const f32x4 v = s[64 * j]; if (isx) ((f32x4*)(a.out + (size_t)rr * D))[lane + 64 * j] = v;
            u32x2 w; w.x = pk2(v[0], v[1]); w.y = pk2(v[2], v[3]); o[64 * j] = w; }
    }
}

__device__ __forceinline__ void ln_phase(const Args& a, unsigned char* ws, int li, int gw, int ngw, int lane) {
    const float* g = a.ln_g + (size_t)li * D; const float* b = a.ln_b + (size_t)li * D;
    bf16* xb = (bf16*)(ws + WS_XB);
    f32x4 gg[4], bb[4];
#pragma unroll
    for (int j = 0; j < 4; ++j) { gg[j] = ((const f32x4*)g)[lane + 64 * j]; bb[j] = ((const f32x4*)b)[lane + 64 * j]; }
    for (int row = gw; row < M; row += ngw) {
        f32x4* tr = (f32x4*)(a.out + (size_t)row * D) + lane;
        f32x4 v[4]; float s = 0.f;
#pragma unroll
        for (int j = 0; j < 4; ++j) { v[j] = tr[64 * j]; s += (v[j][0] + v[j][1]) + (v[j][2] + v[j][3]); }
        const float mean = wave_sum(s) * (1.f / D); float s2 = 0.f;
#pragma unroll
        for (int j = 0; j < 4; ++j) { v[j] = v[j] - mean; s2 += (v[j][0] * v[j][0] + v[j][1] * v[j][1]) + (v[j][2] * v[j][2] + v[j][3] * v[j][3]); }
        const float rstd = rsqrtf(wave_sum(s2) * (1.f / D) + LN_EPS);
        u32x2* o = (u32x2*)(xb + (size_t)row * D) + lane;
#pragma unroll
        for (int j = 0; j < 4; ++j) { const f32x4 y = v[j] * rstd * gg[j] + bb[j]; tr[64 * j] = y; u32x2 w; w.x = pk2(y[0], y[1]); w.y = pk2(y[2], y[3]); o[64 * j] = w; }
    }
}

__device__ __forceinline__ void memattn_phase(unsigned char* ws, LAS unsigned char* lds, int ldp, int mq_off, int wg, int nwg) {
    const bf16* proj = (const bf16*)(ws + WS_HP); const bf16* memkv = (const bf16*)(ws + WS_MEMKV); bf16* heads = (bf16*)(ws + WS_HEADS);
    LAS float* qs = (LAS float*)lds;
    LAS float* ps = (LAS float*)(lds + 2048);
    int tid_l = threadIdx.x; asm volatile("" : "+v"(tid_l)); const int tid = tid_l, slot = tid >> 8, hm = (tid >> 6) & 3, lane = tid & 63;
    for (int t0 = wg * 2; t0 < M; t0 += nwg * 2) {
        const int t = t0 + slot, b = t / SEQ;
        const bf16* mk = memkv + (size_t)b * NMEM * 512;
        __syncthreads();
        qs[(slot * 4 + hm) * 64 + lane] = bf2f(proj[(size_t)t * ldp + mq_off + hm * 64 + lane]);
        __syncthreads();
        float s[4];
#pragma unroll
        for (int i = 0; i < 4; ++i) { const int m = lane + 64 * i; const bf16x8* kr = (const bf16x8*)(mk + (size_t)m * 512 + hm * 64); float acc = 0.f;
#pragma unroll
            for (int d8 = 0; d8 < 8; ++d8) { const bf16x8 kv = kr[d8];
#pragma unroll
                for (int j = 0; j < 8; ++j) acc = fmaf(qs[(slot * 4 + hm) * 64 + d8 * 8 + j], bf2f((unsigned short)kv[j]), acc); }
            s[i] = acc * 0.125f; }
        const float mx = wave_max(fmaxf(fmaxf(s[0], s[1]), fmaxf(s[2], s[3])));
        float e[4], es = 0.f;
#pragma unroll
        for (int i = 0; i < 4; ++i) { e[i] = __expf(s[i] - mx); es += e[i]; }
        const float inv = 1.f / wave_sum(es);
#pragma unroll
        for (int i = 0; i < 4; ++i) ps[(slot * 4 + hm) * 256 + lane + 64 * i] = e[i] * inv;
        __syncthreads();
        float o = 0.f;
        for (int m = 0; m < 256; ++m) o = fmaf(ps[(slot * 4 + hm) * 256 + m], bf2f(mk[(size_t)m * 512 + 256 + hm * 64 + lane]), o);
        heads[(size_t)t * D + C + hm * 64 + lane] = (bf16)f2bf(o);
    }
    __syncthreads();
}

__device__ __forceinline__ void sb_phase(unsigned char* ws, LAS unsigned char* lds, int wg, int nwg) {
    const bf16* proj = (const bf16*)(ws + WS_HP); bf16* heads = (bf16*)(ws + WS_HEADS);
    LAS float* Ks = (LAS float*)lds;
    LAS float* Vs = (LAS float*)(lds + 17408);
    LAS float* Qp = (LAS float*)(lds + 34816);
    LAS float* At = (LAS float*)(lds + 36864);
    LAS float* Qs = (LAS float*)(lds + 54272);
    int tid_l = threadIdx.x; asm volatile("" : "+v"(tid_l)); const int tid = tid_l, qi = tid & 63, kq = tid >> 6;
    for (int u = wg; u < NB * NH * 32; u += nwg) {
        const int bh = u % (NB * NH), qt = u / (NB * NH), b = bh / NH, h = bh % NH;
        const bf16* pb = proj + (size_t)b * SEQ * SB_IN;
        const int t = qt * 64 + qi;
        __syncthreads();
        if (kq == 0) {
#pragma unroll
            for (int d8 = 0; d8 < 8; ++d8) { const bf16x8 v = *(const bf16x8*)(pb + (size_t)t * SB_IN + h * 64 + d8 * 8);
#pragma unroll
                for (int j = 0; j < 8; ++j) Qs[qi * 68 + d8 * 8 + j] = bf2f((unsigned short)v[j]) * 0.125f; }
        }
        float acc[8];
#pragma unroll
        for (int d = 0; d < 8; ++d) acc[d] = 0.f;
        float carry = 1.f;
        for (int kt = qt; kt >= 0; --kt) {
            __syncthreads();
            { const int r = tid >> 3, c8 = (tid & 7) * 8;
              const bf16x8 kv = *(const bf16x8*)(pb + (size_t)(kt * 64 + r) * SB_IN + C + h * 64 + c8);
              const bf16x8 vv = *(const bf16x8*)(pb + (size_t)(kt * 64 + r) * SB_IN + 2 * C + h * 64 + c8);
#pragma unroll
              for (int j = 0; j < 8; ++j) { Ks[r * 68 + c8 + j] = bf2f((unsigned short)kv[j]); Vs[r * 68 + c8 + j] = bf2f((unsigned short)vv[j]); } }
            __syncthreads();
            float sg[8], lp[8]; float run = 1.f;
#pragma unroll
            for (int i = 7; i >= 0; --i) {
                const int kl = kq * 8 + i, s = kt * 64 + kl; float z = 0.f;
#pragma unroll
                for (int d = 0; d < 64; d += 4) { const f32x4 kv = *(const LAS f32x4*)&Ks[kl * 68 + d]; const f32x4 qv = *(const LAS f32x4*)&Qs[qi * 68 + d]; z = fmaf(qv[0], kv[0], z); z = fmaf(qv[1], kv[1], z); z = fmaf(qv[2], kv[2], z); z = fmaf(qv[3], kv[3], z); }
                const float e = __expf(-fabsf(z)), r = 1.f / (1.f + e), big = r, small = e * r;
                const bool before = s < t;
                const float sig = before ? (z >= 0.f ? big : small) : 0.f, keep = before ? (z >= 0.f ? small : big) : 1.f;
                sg[i] = sig; lp[i] = run; run *= keep;
            }
            Qp[kq * 64 + qi] = run;
            __syncthreads();
            float fac = carry;
#pragma unroll
            for (int x = 7; x >= 0; --x) { const float qv = Qp[x * 64 + qi]; if (x > kq) fac *= qv; carry *= qv; }
#pragma unroll
            for (int i = 0; i < 8; ++i) At[qi * 68 + kq * 8 + i] = sg[i] * lp[i] * fac;
            __syncthreads();
#pragma unroll 4
            for (int k4 = 0; k4 < 64; k4 += 4) {
                const f32x4 at = *(const LAS f32x4*)&At[qi * 68 + k4];
#pragma unroll
                for (int j = 0; j < 4; ++j) { const f32x4 v0 = *(const LAS f32x4*)&Vs[(k4 + j) * 68 + kq * 8], v1 = *(const LAS f32x4*)&Vs[(k4 + j) * 68 + kq * 8 + 4];
                    acc[0] = fmaf(at[j], v0[0], acc[0]); acc[1] = fmaf(at[j], v0[1], acc[1]); acc[2] = fmaf(at[j], v0[2], acc[2]); acc[3] = fmaf(at[j], v0[3], acc[3]);
                    acc[4] = fmaf(at[j], v1[0], acc[4]); acc[5] = fmaf(at[j], v1[1], acc[5]); acc[6] = fmaf(at[j], v1[2], acc[6]); acc[7] = fmaf(at[j], v1[3], acc[7]); }
            }
        }
        u32x4 o; o.x = pk2(acc[0], acc[1]); o.y = pk2(acc[2], acc[3]); o.z = pk2(acc[4], acc[5]); o.w = pk2(acc[6], acc[7]);
        *(u32x4*)(heads + ((size_t)b * SEQ + t) * D + h * 64 + kq * 8) = o;
    }
    __syncthreads();
}

template <int KS> __device__ __forceinline__ void mma32(f32x16& acc, const LAS bf16* A, int lda, const LAS bf16* B, int ldb, int lane) {
    const int r = lane & 31, hh = lane >> 5;
#pragma unroll
    for (int ks = 0; ks < KS; ++ks) {
        const bf16x8 av = *(const LAS bf16x8*)(A + r * lda + ks * 16 + hh * 8);
        const bf16x8 bv = *(const LAS bf16x8*)(B + r * ldb + ks * 16 + hh * 8);
        acc = __builtin_amdgcn_mfma_f32_32x32x16_bf16(av, bv, acc, 0, 0, 0);
    }
}
constexpr int RK_CH = 32;
constexpr int RL_RZ = 0, RL_KZ = 8192, RL_VZ = 16384, RL_WL = 24576, RL_AL = 32768, RL_GG = 40960, RL_LO = 49152, RL_SV = 66048, RL_SC = 107008, RL_LW = 107520, RL_END = 143360;
constexpr int LO_LD = 264, LW_LD = 72, LG_LD = 136;
static_assert(RL_END <= LDS_BYTES, "rwkv lds");
__device__ __forceinline__ void rwkv_phase(const Args& a, unsigned char* ws, LAS unsigned char* lds, int unit) {
    int tid_l = threadIdx.x; asm volatile("" : "+v"(tid_l)); const int b = unit / NH, h = unit % NH, tid = tid_l, lane = tid & 63, wave = tid >> 6;
    const bf16* proj = (const bf16*)(ws + WS_HP) + (size_t)b * SEQ * RW_IN; bf16* heads = (bf16*)(ws + WS_HEADS) + (size_t)b * SEQ * D;
    LAS float* RZ = (LAS float*)(lds + RL_RZ); LAS float* KZ = (LAS float*)(lds + RL_KZ); LAS float* VZ = (LAS float*)(lds + RL_VZ);
    LAS float* WL = (LAS float*)(lds + RL_WL); LAS float* AL = (LAS float*)(lds + RL_AL); LAS float* GG = (LAS float*)(lds + RL_GG);
    LAS bf16* LO = (LAS bf16*)(lds + RL_LO); LAS float* SV = (LAS float*)(lds + RL_SV); LAS float* SC = (LAS float*)(lds + RL_SC);
    LAS bf16* LWw = (LAS bf16*)(lds + RL_LW); LAS bf16* LWa = LWw + 64 * LW_LD; LAS bf16* LWg = LWa + 64 * LW_LD;
    LAS float* OUT = KZ;
    { const bf16* gw_ = (const bf16*)(ws + WS_LW) + (size_t)h * 64 * 64; const bf16* ga_ = (const bf16*)(ws + WS_LW) + (size_t)768 * 64 + (size_t)h * 64 * 64;
      const bf16* gg_ = (const bf16*)(ws + WS_LW) + (size_t)768 * 128 + (size_t)h * 64 * 128;
      for (int i = tid; i < 64 * 64; i += NT) { const int n = i >> 6, k = i & 63; LWw[n * LW_LD + k] = gw_[i]; LWa[n * LW_LD + k] = ga_[i]; }
      for (int i = tid; i < 64 * 128; i += NT) { const int n = i >> 7, k = i & 127; LWg[n * LG_LD + k] = gg_[i]; } }
    const int cl = lane;
    const int ch = h * 64 + cl;
    const float c_w0 = a.w0[ch], c_a0 = a.a0[ch], c_kk = a.k_k[ch], c_ka = a.k_a[ch], c_rk = a.r_k[ch], c_lg = a.lnx_g[ch], c_lb = a.lnx_b[ch];
    const int jg = lane & 15, r0 = wave * 8 + (lane >> 4) * 2;
    f32x4 S0 = {0.f, 0.f, 0.f, 0.f}, S1 = {0.f, 0.f, 0.f, 0.f};
    __syncthreads();
    for (int t0 = 0; t0 < SEQ; t0 += RK_CH) {
        for (int i = tid; i < RK_CH * 448; i += NT) {
            const int tt = i / 448, cc = i % 448, t = t0 + tt;
            int col, mcol;
            if (cc < 192) { const int which = cc >> 6; col = which * C + h * 64 + (cc & 63); } else col = 3 * C + (cc - 192);
            mcol = col;
            const float cur = bf2f(proj[(size_t)t * RW_IN + col]); const float prev = t > 0 ? bf2f(proj[(size_t)(t - 1) * RW_IN + col]) : 0.f;
            const float z = cur + (prev - cur) * a.mu[mcol];
            if (cc < 64) RZ[tt * 64 + cc] = z; else if (cc < 128) KZ[tt * 64 + (cc - 64)] = z; else if (cc < 192) VZ[tt * 64 + (cc - 128)] = z;
            else { const int l = cc - 192; const float v = l < 64 ? tanhf(z) : (l < 128 ? z : sigmoidf_(z)); LO[tt * LO_LD + l] = (bf16)f2bf(v); }
        }
        __syncthreads();
        if (wave < 6) {
            const int mat = wave >> 1, nt = wave & 1;
            f32x16 acc = {0.f, 0.f, 0.f, 0.f, 0.f, 0.f, 0.f, 0.f, 0.f, 0.f, 0.f, 0.f, 0.f, 0.f, 0.f, 0.f};
            if (mat == 0) mma32<4>(acc, LO, LO_LD, LWw + nt * 32 * LW_LD, LW_LD, lane);
            else if (mat == 1) mma32<4>(acc, LO + 64, LO_LD, LWa + nt * 32 * LW_LD, LW_LD, lane);
            else mma32<8>(acc, LO + 128, LO_LD, LWg + nt * 32 * LG_LD, LG_LD, lane);
            LAS float* dst = mat == 0 ? WL : (mat == 1 ? AL : GG);
#pragma unroll
            for (int r = 0; r < 16; ++r) { const int tok = (r & 3) + 8 * (r >> 2) + 4 * (lane >> 5); dst[tok * 64 + nt * 32 + (lane & 31)] = acc[r]; }
        }
        __syncthreads();
#pragma unroll 1
        for (int q = 0; q < 4; ++q) {
            const int tt = wave * 4 + q;
            const float wl = c_w0 + WL[tt * 64 + cl], al = c_a0 + AL[tt * 64 + cl];
            const float wlog = -softplusf_(-wl) - 0.5f, w = __expf(-__expf(wlog)), aa = sigmoidf_(al);
            const float r = RZ[tt * 64 + cl], kraw = KZ[tt * 64 + cl];
            const float kkr = kraw * c_kk, ss = wave_sum(kkr * kkr), kkn = kkr * rsqrtf(fmaxf(ss, 1e-24f));
            const float k = kraw * (1.f + (aa - 1.f) * c_ka), bb = kkn * aa;
            const float br = wave_sum(bb * r), kr = wave_sum(k * r), bon = wave_sum(r * k * c_rk);
            LAS float* sv = SV + tt * 320;
            sv[cl] = kkn; sv[64 + cl] = w * r; sv[128 + cl] = w; sv[192 + cl] = bb; sv[256 + cl] = k;
            if (lane == 0) { SC[tt * 4 + 0] = br; SC[tt * 4 + 1] = kr; SC[tt * 4 + 2] = bon; }
        }
        __syncthreads();
#pragma unroll 2
        for (int tt = 0; tt < RK_CH; ++tt) {
            const LAS float* sv = SV + tt * 320 + 4 * jg;
            const f32x4 k4 = *(const LAS f32x4*)(sv), r4 = *(const LAS f32x4*)(sv + 64), w4 = *(const LAS f32x4*)(sv + 128), b4 = *(const LAS f32x4*)(sv + 192), q4 = *(const LAS f32x4*)(sv + 256);
            const float v0 = VZ[tt * 64 + r0], v1 = VZ[tt * 64 + r0 + 1], br = SC[tt * 4 + 0], kr = SC[tt * 4 + 1];
            float sa0 = (S0[0] * k4[0] + S0[1] * k4[1]) + (S0[2] * k4[2] + S0[3] * k4[3]);
            float p0 = (S0[0] * r4[0] + S0[1] * r4[1]) + (S0[2] * r4[2] + S0[3] * r4[3]);
            float sa1 = (S1[0] * k4[0] + S1[1] * k4[1]) + (S1[2] * k4[2] + S1[3] * k4[3]);
            float p1 = (S1[0] * r4[0] + S1[1] * r4[1]) + (S1[2] * r4[2] + S1[3] * r4[3]);
            sa0 = rowsum16(sa0); p0 = rowsum16(p0); sa1 = rowsum16(sa1); p1 = rowsum16(p1);
            if (jg == 0) { OUT[tt * 64 + r0] = p0 - sa0 * br + v0 * kr; OUT[tt * 64 + r0 + 1] = p1 - sa1 * br + v1 * kr; }
            S0 = S0 * w4 - b4 * sa0 + q4 * v0;
            S1 = S1 * w4 - b4 * sa1 + q4 * v1;
        }
        __syncthreads();
#pragma unroll 1
        for (int q = 0; q < 4; ++q) {
            const int tt = wave * 4 + q;
            const float o = OUT[tt * 64 + cl];
            const float m = wave_sum(o) * (1.f / 64.f), d = o - m, var = wave_sum(d * d) * (1.f / 64.f);
            const float y = d * rsqrtf(var + LNX_EPS) * c_lg + c_lb;
            const float res = (y + SC[tt * 4 + 2] * VZ[tt * 64 + cl]) * GG[tt * 64 + cl];
            heads[(size_t)(t0 + tt) * D + ch] = (bf16)f2bf(res);
        }
        __syncthreads();
    }
}

__global__ void __launch_bounds__(NT, 2) mega(Args a) {
    extern __shared__ __attribute__((aligned(16))) unsigned char lds_raw[];
    LAS unsigned char* lds = (LAS unsigned char*)lds_raw;
    cg::grid_group grid = cg::this_grid();
    const bool coop = (a.ph_hi - a.ph_lo) > 1;
#pragma unroll 1
    for (int ph = a.ph_lo; ph < a.ph_hi; ++ph) {
        int p = ph; asm volatile("" : "+s"(p));
        unsigned char* ws = a.ws; asm volatile("" : "+s"(ws));
        int tid_l = threadIdx.x; asm volatile("" : "+v"(tid_l));
        const int tid = tid_l, lane = tid & 63, wave = __builtin_amdgcn_readfirstlane(tid >> 6);
        const int G = gridDim.x, wg = blockIdx.x, gw = wg * NWAVES + wave, ngw = G * NWAVES;
        bf16* xb = (bf16*)(ws + WS_XB); bf16* hp = (bf16*)(ws + WS_HP); bf16* heads = (bf16*)(ws + WS_HEADS);
        if (p == 0) { p0_prologue(a, lds, gw, ngw, wave, lane); __syncthreads(); }
        else {
            const int L = (p - 1) / 10, sub = (p - 1) % 10;
            if (sub == 0 || sub == 7) {
                const int fi = L * 2 + (sub == 7 ? 1 : 0);
                { pg8::Gemm g{xb, (const bf16*)(ws + WS_WGU) + (size_t)fi * 2 * FF * D, M, 2 * FF, D}; pg8::StaticOrder S; S.init(M, 2 * FF, G, wg);
                  pg8::EpiSwiglu E{hp, FF};
                  pg8::gemm_phase<pg8::EpiSwiglu, pg8::StaticOrder, true, true>(lds, g, S, E); }
            } else if (sub == 1 || sub == 8) {
                const int fi = L * 2 + (sub == 8 ? 1 : 0);
                pg8::Gemm g{hp, (const bf16*)(ws + WS_WD) + (size_t)fi * FF * D, M, D, FF}; pg8::StaticOrder S; S.init(M, D, G, wg);
                pg8::EpiRes E{a.out, ALPHA, 0.5f};
                pg8::gemm_phase<pg8::EpiRes, pg8::StaticOrder, true, true>(lds, g, S, E);
            } else if (sub == 5) {
                pg8::Gemm g{heads, (const bf16*)(ws + WS_WOUT) + (size_t)L * D * D, M, D, D}; pg8::StaticOrder S; S.init(M, D, G, wg);
                pg8::EpiRes E{a.out, ALPHA, 1.0f};
                pg8::gemm_phase<pg8::EpiRes, pg8::StaticOrder, true, true>(lds, g, S, E);
            } else if (sub == 2 || sub == 6 || sub == 9) {
                ln_phase(a, ws, L * 3 + (sub == 2 ? 0 : (sub == 6 ? 1 : 2)), gw, ngw, lane);
            } else if (sub == 3) {
                const int nrep = L == 0 ? 2 : 1;
#pragma unroll 1
                for (int rep = 0; rep < nrep; ++rep) {
                    int rp = rep; asm volatile("" : "+s"(rp));
                    const int N = rp == 1 ? 512 : (L == 0 ? RW_IN : SB_IN), Mr = rp == 1 ? NB * NMEM : M;
                    pg8::Gemm g{rp == 1 ? (const bf16*)(ws + WS_MEMB) : xb, (const bf16*)(ws + (rp == 1 ? WS_WMKV : (L == 0 ? WS_WIN0 : WS_WIN1))), Mr, N, D}; pg8::StaticOrder S; S.init(Mr, N, G, wg);
                    pg8::EpiBf16<0> E{rp == 1 ? (bf16*)(ws + WS_MEMKV) : hp, N, nullptr, 0, 0, 1.f};
                    pg8::gemm_phase<pg8::EpiBf16<0>, pg8::StaticOrder, true, true>(lds, g, S, E);
                }
            } else {
                if (L == 0) {
                    if (wg < NB * NH) rwkv_phase(a, ws, lds, wg);
                    else memattn_phase(ws, lds, RW_IN, RW_SHIFT, wg - NB * NH, G - NB * NH);
                } else {
                    sb_phase(ws, lds, wg, G);
                    memattn_phase(ws, lds, SB_IN, 3 * C, wg, G);
                }
            }
        }
        if (coop && ph + 1 < a.ph_hi) grid.sync();
    }
}
constexpr int NPHASES = 1 + 2 * (3 + 4 + 3);

extern "C" void kernel_launch(void* const* d_in, const int* in_sizes, int n_in, void* d_out, int out_size, void* d_ws, size_t ws_size, hipStream_t stream) {
    static int grid = 0;
    if (grid == 0) {
        if (n_in != 25 || out_size != M * D || ws_size < WS_END) { fprintf(stderr, "kernel_launch: unexpected shapes (n_in %d out %d ws %zu)\n", n_in, out_size, ws_size); grid = -1; return; }
        int dev = 0, cus = 0, per_cu = 0;
        (void)hipGetDevice(&dev); (void)hipDeviceGetAttribute(&cus, hipDeviceAttributeMultiprocessorCount, dev);
        if (hipFuncSetAttribute((const void*)mega, hipFuncAttributeMaxDynamicSharedMemorySize, LDS_BYTES) != hipSuccess) { fprintf(stderr, "kernel_launch: hipFuncSetAttribute failed\n"); grid = -1; return; }
        if (hipOccupancyMaxActiveBlocksPerMultiprocessor(&per_cu, (const void*)mega, NT, LDS_BYTES) != hipSuccess || per_cu < 1) { fprintf(stderr, "kernel_launch: occupancy query failed (%d)\n", per_cu); per_cu = 1; }
        (void)hipGetLastError();
        grid = cus;
        fprintf(stderr, "kernel_launch: cus %d per_cu %d grid %d\n", cus, per_cu, grid);
    }
    if (grid < 0) return;
    Args a{};
    const float* const* in = (const float* const*)d_in;
    a.x = in[0]; a.mem = in[1]; a.ln_g = in[8]; a.ln_b = in[9];
    a.mu = in[13]; a.w0 = in[14]; a.a0 = in[16]; a.k_k = in[19]; a.k_a = in[20]; a.r_k = in[21]; a.lnx_g = in[22]; a.lnx_b = in[23];
    a.out = (float*)d_out; a.ws = (unsigned char*)d_ws;
    unsigned char* ws = (unsigned char*)d_ws;
    int nd = 0, first = 0;
    auto add = [&](const float* src, bf16* dst, int K, int N, int mode) { a.td[nd] = TDesc{src, dst, K, N, mode, first}; first += (K / 64) * (N / 32); ++nd; };
    for (int layer = 0; layer < 2; ++layer)
        for (int f = 0; f < 2; ++f) {
            const int fi = layer * 2 + f; bf16* gu = (bf16*)(ws + WS_WGU) + (size_t)fi * 2 * FF * D;
            add(in[f == 0 ? 2 : 5] + (size_t)layer * D * FF, gu, D, FF, 1);
            add(in[f == 0 ? 3 : 6] + (size_t)layer * D * FF, gu, D, FF, 2);
            add(in[f == 0 ? 4 : 7] + (size_t)layer * FF * D, (bf16*)(ws + WS_WD) + (size_t)fi * FF * D, FF, D, 0);
        }
    add(in[12], (bf16*)(ws + WS_WIN0), D, RW_IN, 0);
    add(in[24], (bf16*)(ws + WS_WIN1), D, SB_IN, 0);
    add(in[10], (bf16*)(ws + WS_WOUT), D, D, 0);
    add(in[10] + (size_t)D * D, (bf16*)(ws + WS_WOUT) + (size_t)D * D, D, D, 0);
    add(in[11], (bf16*)(ws + WS_WMKV), D, 512, 0);
    add(in[15], (bf16*)(ws + WS_LW), 64, C, 0);
    add(in[17], (bf16*)(ws + WS_LW) + (size_t)768 * 64, 64, C, 0);
    add(in[18], (bf16*)(ws + WS_LW) + (size_t)768 * 128, 128, C, 0);
    for (; nd < NDESC; ++nd) a.td[nd] = TDesc{nullptr, nullptr, 64, 32, 0, 0x7fffffff};
    a.nitems = first;
#ifndef MK_SPLIT
    a.ph_lo = 0; a.ph_hi = NPHASES;
    void* args[] = {&a};
    hipError_t e = hipLaunchCooperativeKernel((const void*)mega, dim3(grid), dim3(NT), args, LDS_BYTES, stream);
    if (e != hipSuccess) fprintf(stderr, "cooperative launch failed: %s (grid %d)\n", hipGetErrorString(e), grid);
#else
    for (int p = 0; p < NPHASES; ++p) { a.ph_lo = p; a.ph_hi = p + 1; hipLaunchKernelGGL(mega, dim3(grid), dim3(NT), LDS_BYTES, stream, a); }
#endif
}
```

```cpp
#include <hip/hip_runtime.h>
#include <hip/hip_cooperative_groups.h>
#include <cstdio>
#include <cstdint>
namespace cg = cooperative_groups;
namespace pg8 {
#define PG8_LAS __attribute__((address_space(3)))
typedef unsigned short bf16_t;
typedef short bf16x8 __attribute__((ext_vector_type(8)));
typedef float f32x4 __attribute__((ext_vector_type(4)));
typedef unsigned u32x4 __attribute__((ext_vector_type(4)));
constexpr int BM = 256, BK = 64, HALF = 128, HTB = HALF * BK * 2  , STAGE_BYTES = 8 * HTB, NXCD = 8, WGM = 8;

__host__ __device__ __forceinline__ int lds_byte(int r, int c) { const int st = (r >> 4) * 2 + (c >> 5), rr = r & 15, cc = c & 31, ob = rr * 64 + cc * 2; return st * 1024 + (ob ^ (((ob >> 9) & 1) << 5)); }
__host__ __device__ __forceinline__ void stage_rc(int b, int& R, int& C) { const int st = b / 1024, sb = b % 1024, swz = sb ^ (((sb >> 9) & 1) << 5); R = (st >> 1) * 16 + swz / 64; C = (st & 1) * 32 + (swz % 64) / 2; }
__host__ __device__ __forceinline__ int perm32(int rho) { const int n = rho >> 4, i = rho & 15; return 8 * (i >> 2) + 4 * n + (i & 3); }

struct Unit { int pm, pn; };
struct Gemm { const bf16_t* A; const bf16_t* Bt; int M, N, K; };

struct StaticOrder {
    int nM, nN, nwg, G, c;
    __host__ __device__ void init(int M, int N, int G_, int c_) { nM = M / BM; nN = N / BM; nwg = nM * nN; G = G_; c = c_; }
    __host__ __device__ bool next(int i, Unit& u) const {
        const long L = (long)i * G + c; if (L >= nwg) return false;
        int wgid = (int)L; { const int q = nwg / NXCD, r = nwg % NXCD, xcd = wgid % NXCD, off = wgid / NXCD; wgid = (xcd < r ? xcd * (q + 1) : r * (q + 1) + (xcd - r) * q) + off; }
        const int nig = WGM * nN, gid = wgid / nig, fm = gid * WGM, gsz = (nM - fm) < WGM ? (nM - fm) : WGM;
        u.pm = fm + ((wgid % nig) % gsz); u.pn = (wgid % nig) / gsz; return true;
    }
    __device__ __forceinline__ void a_ready(const Unit&) const {}
    __device__ __forceinline__ void done(const Unit&) const {}
};

__device__ __forceinline__ unsigned cvt_pk_bf16(float lo, float hi) { unsigned r; asm volatile("v_cvt_pk_bf16_f32 %0, %1, %2" : "=v"(r) : "v"(lo), "v"(hi)); return r; }
typedef float f32x2 __attribute__((ext_vector_type(2)));
__device__ __forceinline__ f32x2 gelu_pk(f32x2 v) {
    const f32x2 av = __builtin_elementwise_abs(v), d = av * 0.2316418882f + 1.0f;
    f32x2 t; t.x = __builtin_amdgcn_rcpf(d.x); t.y = __builtin_amdgcn_rcpf(d.y);
    f32x2 q = t * 0.5307027145f + (-0.7265760135f); q = q * t + 0.7107068705f; q = q * t + (-0.142248368f); q = q * t + 0.127414796f; q = q * t;
    const f32x2 s = (v * v) * (-0.72134752044f);
    f32x2 e; e.x = __builtin_amdgcn_exp2f(s.x); e.y = __builtin_amdgcn_exp2f(s.y);
    const f32x2 m = v * (q * e), r = v - m;
    f32x2 o; o.x = v.x < 0.f ? m.x : r.x; o.y = v.y < 0.f ? m.y : r.y; return o;
}

template <int ACT  > struct EpiBf16 {
    static constexpr bool PERM = true, AFTER_DRAIN = false; static_assert(ACT == 0 || ACT == 1, "EpiBf16: ACT is 0 (none) or 1 (gelu_pk)");
    bf16_t* O; int ldc; const float* bias; int split_cols; size_t split_stride; float scale0;
    __device__ __forceinline__ void operator()(const f32x4 (&acc)[2][2][4][2], const Unit& u, int wr, int wc, int fr, int fq) const {
        const int row0 = u.pm * BM + wr * 64 + fr; int colt = u.pn * BM; bf16_t* base = O;
        float sc = 1.f; if (split_cols) { const int t = colt / split_cols; base += (size_t)t * split_stride; colt -= t * split_cols; if (t == 0) sc = scale0; }
        const int col0 = colt + wc * 32 + 8 * fq, bcol0 = u.pn * BM + wc * 32 + 8 * fq;
        f32x4 bv[2][2];
#pragma unroll
        for (int bj = 0; bj < 2; ++bj)
#pragma unroll
            for (int n = 0; n < 2; ++n) bv[bj][n] = bias ? *(const f32x4*)(bias + bcol0 + bj * HALF + 4 * n) : (f32x4){0.f, 0.f, 0.f, 0.f};
#pragma unroll
        for (int ai = 0; ai < 2; ++ai)
#pragma unroll
            for (int m = 0; m < 4; ++m) { bf16_t* rowp = base + (size_t)(row0 + ai * HALF + m * 16) * ldc + col0;
#pragma unroll
                for (int bj = 0; bj < 2; ++bj) { f32x4 v0 = acc[ai][bj][m][0] + bv[bj][0], v1 = acc[ai][bj][m][1] + bv[bj][1];
                    if (ACT == 1) { f32x2 a = gelu_pk((f32x2){v0[0], v0[1]}), b = gelu_pk((f32x2){v0[2], v0[3]}), c = gelu_pk((f32x2){v1[0], v1[1]}), d = gelu_pk((f32x2){v1[2], v1[3]});
                        v0 = (f32x4){a.x, a.y, b.x, b.y}; v1 = (f32x4){c.x, c.y, d.x, d.y}; }
                    v0 = v0 * sc; v1 = v1 * sc; u32x4 w; w.x = cvt_pk_bf16(v0[0], v0[1]); w.y = cvt_pk_bf16(v0[2], v0[3]); w.z = cvt_pk_bf16(v1[0], v1[1]); w.w = cvt_pk_bf16(v1[2], v1[3]);
                    *(u32x4*)(rowp + bj * HALF) = w; } }
    }
};

template <class Epi, class Sched, bool ALIGN_EPI = false, bool SP2 = false>
__device__ __forceinline__ void gemm_phase(PG8_LAS unsigned char* lds, const Gemm g, const Sched& S, const Epi& E) {
    int tid_l = threadIdx.x; asm volatile("" : "+v"(tid_l));
    const int tid = tid_l, wid = __builtin_amdgcn_readfirstlane(tid >> 6), lane = tid & 63, wr = wid >> 2, wc = wid & 3, fr = lane & 15, fq = lane >> 4;
    const int K = g.K, nt = K / BK;
    unsigned voffA[2], voffB[2];
#pragma unroll
    for (int i = 0; i < 2; ++i) { int R, C; stage_rc(tid * 16 + i * 8192, R, C); const int Rb = Epi::PERM ? ((R & ~31) + perm32(R & 31)) : R;
        voffA[i] = (unsigned)(R * K + C) * 2u; voffB[i] = (unsigned)(Rb * K + C) * 2u; }
    const size_t kstep = (size_t)(BK * 2);
    const size_t hstep = (size_t)HALF * K * 2;
    const size_t tstep = 2 * hstep;
    const unsigned ldsw = (unsigned)wid * 1024u;
    const int aoff = lds_byte(wr * 64 + fr, fq * 8), boff = lds_byte(wc * 32 + fr, fq * 8);
#define PG8_SA(b, h) (((b) * 2 + (h)) * HTB)
#define PG8_SB(b, h) ((4 + (b) * 2 + (h)) * HTB)
#define PG8_STAGE(bufoff, gbase, voff) do { _Pragma("unroll") for (int _i = 0; _i < 2; ++_i) \
        __builtin_amdgcn_global_load_lds((const unsigned*)((const char*)(gbase) + (voff)[_i]), (PG8_LAS unsigned*)(lds + (bufoff) + ldsw + _i * 8192), 16, 0, 0); } while (0)
#define PG8_LDA(dst, b, h) do { _Pragma("unroll") for (int m = 0; m < 4; ++m) _Pragma("unroll") for (int k = 0; k < 2; ++k) dst[m][k] = *(const PG8_LAS bf16x8*)(lds + PG8_SA(b, h) + aoff + m * 2048 + k * 1024); } while (0)
#define PG8_LDB(dst, b, h) do { _Pragma("unroll") for (int n = 0; n < 2; ++n) _Pragma("unroll") for (int k = 0; k < 2; ++k) dst[n][k] = *(const PG8_LAS bf16x8*)(lds + PG8_SB(b, h) + boff + n * 2048 + k * 1024); } while (0)
#define PG8_MMA(ai, bj, At, Bt) do { __builtin_amdgcn_s_setprio(1); _Pragma("unroll") for (int m = 0; m < 4; ++m) _Pragma("unroll") for (int n = 0; n < 2; ++n) _Pragma("unroll") for (int k = 0; k < 2; ++k) \
        acc[ai][bj][m][n] = __builtin_amdgcn_mfma_f32_16x16x32_bf16(Bt[n][k], At[m][k], acc[ai][bj][m][n], 0, 0, 0); __builtin_amdgcn_s_setprio(0); } while (0)
#define PG8_WAIT_V(n) asm volatile("s_waitcnt vmcnt(" #n ")" ::: "memory")
#define PG8_WAIT_L(n) asm volatile("s_waitcnt lgkmcnt(" #n ")" ::: "memory")
#define PG8_BAR __builtin_amdgcn_s_barrier()
#define PG8_SCHED __builtin_amdgcn_sched_barrier(0)
    Unit cur, nxt; int ui = 0;
    if (!S.next(0, cur)) return;
    f32x4 acc[2][2][4][2];
#pragma unroll
    for (int a = 0; a < 2; ++a)
#pragma unroll
        for (int b = 0; b < 2; ++b)
#pragma unroll
            for (int m = 0; m < 4; ++m)
#pragma unroll
                for (int n = 0; n < 2; ++n) acc[a][b][m][n] = (f32x4){0.f, 0.f, 0.f, 0.f};
    bf16x8 At[4][2], B0[2][2], B1[2][2];
    const char* cA = (const char*)g.A + (size_t)cur.pm * tstep; const char* cB = (const char*)g.Bt + (size_t)cur.pn * tstep;
    S.a_ready(cur);
    if constexpr (SP2) {
        PG8_STAGE(PG8_SB(0, 0), cB, voffB); PG8_STAGE(PG8_SB(0, 1), cB + hstep, voffB); PG8_STAGE(PG8_SA(0, 0), cA, voffA); PG8_STAGE(PG8_SA(0, 1), cA + hstep, voffA);
        if (wr == 1) PG8_BAR;
        PG8_WAIT_V(2); PG8_BAR;
        PG8_STAGE(PG8_SB(1, 0), cB + kstep, voffB); PG8_STAGE(PG8_SA(1, 0), cA + kstep, voffA); PG8_STAGE(PG8_SB(1, 1), cB + hstep + kstep, voffB);
        PG8_WAIT_V(6); PG8_BAR;
    } else {
        PG8_STAGE(PG8_SB(0, 0), cB, voffB); PG8_STAGE(PG8_SA(0, 0), cA, voffA); PG8_STAGE(PG8_SB(0, 1), cB + hstep, voffB); PG8_STAGE(PG8_SA(0, 1), cA + hstep, voffA);
        if (wr == 1) PG8_BAR;
        PG8_WAIT_V(4); PG8_BAR;
        PG8_STAGE(PG8_SB(1, 0), cB + kstep, voffB); PG8_STAGE(PG8_SA(1, 0), cA + kstep, voffA); PG8_STAGE(PG8_SB(1, 1), cB + hstep + kstep, voffB);
        PG8_WAIT_V(6); PG8_BAR;
    }
    for (;;) {
        const bool has_next = S.next(ui + 1, nxt);
        const char* nA = has_next ? (const char*)g.A + (size_t)nxt.pm * tstep : cA; const char* nB = has_next ? (const char*)g.Bt + (size_t)nxt.pn * tstep : cB;
        for (int t = 0; t < nt; t += 2) {
            const bool last = (t == nt - 2);
            const char* a1 = cA + (size_t)(t + 1) * kstep;
            const char* a2 = last ? nA : cA + (size_t)(t + 2) * kstep; const char* b2 = last ? nB : cB + (size_t)(t + 2) * kstep;
            const char* a3 = a2 + kstep; const char* b3 = b2 + kstep;
            if (last && has_next) S.a_ready(nxt);
            if constexpr (SP2) {
            PG8_LDB(B0, 0, 0); PG8_LDB(B1, 0, 1); PG8_SCHED; PG8_LDA(At, 0, 0); PG8_STAGE(PG8_SA(1, 1), a1 + hstep, voffA);
            PG8_WAIT_V(8); PG8_WAIT_L(0); PG8_BAR; PG8_MMA(0, 0, At, B0); PG8_MMA(0, 1, At, B1); PG8_BAR; PG8_SCHED;
            PG8_LDA(At, 0, 1); PG8_STAGE(PG8_SB(0, 0), b2, voffB); PG8_STAGE(PG8_SB(0, 1), b2 + hstep, voffB); PG8_STAGE(PG8_SA(0, 0), a2, voffA);
            PG8_WAIT_V(8); PG8_WAIT_L(0); PG8_BAR; PG8_MMA(1, 0, At, B0); PG8_MMA(1, 1, At, B1); PG8_BAR; PG8_SCHED;
            PG8_LDB(B0, 1, 0); PG8_LDB(B1, 1, 1); PG8_SCHED; PG8_LDA(At, 1, 0); PG8_STAGE(PG8_SA(0, 1), a2 + hstep, voffA);
            PG8_WAIT_V(8); PG8_WAIT_L(0); PG8_BAR; PG8_MMA(0, 0, At, B0); PG8_MMA(0, 1, At, B1); PG8_BAR; PG8_SCHED;
            PG8_LDA(At, 1, 1); PG8_STAGE(PG8_SB(1, 0), b3, voffB); PG8_STAGE(PG8_SB(1, 1), b3 + hstep, voffB); PG8_STAGE(PG8_SA(1, 0), a3, voffA);
            PG8_WAIT_V(8); PG8_WAIT_L(0); PG8_BAR; PG8_MMA(1, 0, At, B0); PG8_MMA(1, 1, At, B1); PG8_BAR; PG8_SCHED;
            } else {
            PG8_LDB(B0, 0, 0); PG8_SCHED; PG8_LDA(At, 0, 0); PG8_STAGE(PG8_SA(1, 1), a1 + hstep, voffA);
            PG8_WAIT_L(8); PG8_BAR; PG8_WAIT_L(0); PG8_MMA(0, 0, At, B0); PG8_BAR; PG8_SCHED;
            PG8_LDB(B1, 0, 1); PG8_STAGE(PG8_SB(0, 0), b2, voffB);
            PG8_BAR; PG8_WAIT_L(0); PG8_MMA(0, 1, At, B1); PG8_BAR;
            PG8_LDA(At, 0, 1); PG8_STAGE(PG8_SA(0, 0), a2, voffA);
            PG8_BAR; PG8_WAIT_L(0); PG8_MMA(1, 0, At, B0); PG8_BAR; PG8_SCHED;
            PG8_STAGE(PG8_SB(0, 1), b2 + hstep, voffB);
            PG8_WAIT_V(6); PG8_BAR; PG8_MMA(1, 1, At, B1); PG8_BAR;
            PG8_LDB(B0, 1, 0); PG8_SCHED; PG8_LDA(At, 1, 0); PG8_STAGE(PG8_SA(0, 1), a2 + hstep, voffA);
            PG8_WAIT_L(8); PG8_BAR; PG8_WAIT_L(0); PG8_MMA(0, 0, At, B0); PG8_BAR; PG8_SCHED;
            PG8_LDB(B1, 1, 1); PG8_STAGE(PG8_SB(1, 0), b3, voffB);
            PG8_BAR; PG8_WAIT_L(0); PG8_MMA(0, 1, At, B1); PG8_BAR;
            PG8_LDA(At, 1, 1); PG8_STAGE(PG8_SA(1, 0), a3, voffA);
            PG8_BAR; PG8_WAIT_L(0); PG8_MMA(1, 0, At, B0); PG8_BAR; PG8_SCHED;
            PG8_STAGE(PG8_SB(1, 1), b3 + hstep, voffB);
            PG8_WAIT_V(6); PG8_BAR; PG8_MMA(1, 1, At, B1); PG8_BAR;
            }
        }
        if constexpr (ALIGN_EPI) { if (wr == 0) PG8_BAR; }
        if constexpr (!Epi::AFTER_DRAIN) { E(acc, cur, wr, wc, fr, fq); S.done(cur); }
        if (!has_next) break;
#pragma unroll
        for (int a = 0; a < 2; ++a)
#pragma unroll
            for (int b = 0; b < 2; ++b)
#pragma unroll
                for (int m = 0; m < 4; ++m)
#pragma unroll
                    for (int n = 0; n < 2; ++n) acc[a][b][m][n] = (f32x4){0.f, 0.f, 0.f, 0.f};
        cur = nxt; cA = nA; cB = nB; ++ui;
        if constexpr (ALIGN_EPI) { if (wr == 1) PG8_BAR; }
    }
    PG8_WAIT_V(0);
    if constexpr (!ALIGN_EPI) { if (wr == 0) PG8_BAR; }
    PG8_BAR;
    if constexpr (Epi::AFTER_DRAIN) { E.fused(acc, cur, wr, wc, fr, fq, lds, wid, lane); S.done(cur); }
#undef PG8_SA
#undef PG8_SB
#undef PG8_STAGE
#undef PG8_LDA
#undef PG8_LDB
#undef PG8_MMA
#undef PG8_WAIT_V
#undef PG8_WAIT_L
#undef PG8_BAR
#undef PG8_SCHED
}
}

constexpr int D = 1024, NB = 8, SEQ = 2048, M = NB * SEQ, NMEM = 256;
constexpr int C = 768, NH = 12, FF = 2816;
constexpr int RW_SHIFT = 2560, RW_IN = 2816, SB_IN = 2560;
constexpr float ALPHA = 1.41421356237309515f;
constexpr float LN_EPS = 1e-5f, LNX_EPS = 64e-5f;
constexpr int NWAVES = 8, NT = 512;
constexpr int LDS_BYTES = 159744;

#define LAS __attribute__((address_space(3)))
typedef unsigned short bf16;
typedef float f32x4 __attribute__((ext_vector_type(4)));
typedef float f32x16 __attribute__((ext_vector_type(16)));
typedef short bf16x8 __attribute__((ext_vector_type(8)));
typedef unsigned u32x4 __attribute__((ext_vector_type(4)));
typedef unsigned u32x2 __attribute__((ext_vector_type(2)));

constexpr size_t MiB = 1u << 20;
constexpr size_t WS_WGU = 1 * MiB;
constexpr size_t WS_WD = 45 * MiB;
constexpr size_t WS_WIN0 = 67 * MiB;
constexpr size_t WS_WIN1 = WS_WIN0 + (size_t)RW_IN * D * 2;
constexpr size_t WS_WOUT = WS_WIN1 + (size_t)SB_IN * D * 2;
constexpr size_t WS_WMKV = WS_WOUT + 2 * (size_t)D * D * 2;
constexpr size_t WS_LW = WS_WMKV + (size_t)512 * D * 2;
constexpr size_t WS_MEMB = 83 * MiB;
constexpr size_t WS_MEMKV = 87 * MiB;
constexpr size_t WS_XB = 89 * MiB;
constexpr size_t WS_HP = 121 * MiB;
constexpr size_t WS_HEADS = 209 * MiB;
constexpr size_t WS_END = 241 * MiB;
static_assert(WS_LW + (size_t)768 * 256 * 2 <= WS_MEMB, "ws map");

__device__ __forceinline__ unsigned f2bf(float f) { unsigned u = __builtin_bit_cast(unsigned, f); return (u + 0x7fffu + ((u >> 16) & 1u)) >> 16; }
__device__ __forceinline__ unsigned pk2(float lo, float hi) { return f2bf(lo) | (f2bf(hi) << 16); }
__device__ __forceinline__ float bf2f(unsigned short b) { return __builtin_bit_cast(float, (unsigned)b << 16); }
__device__ __forceinline__ float wave_sum(float v) {
#pragma unroll
    for (int o = 1; o < 64; o <<= 1) v += __shfl_xor(v, o);
    return v;
}
__device__ __forceinline__ float wave_max(float v) {
#pragma unroll
    for (int o = 1; o < 64; o <<= 1) v = fmaxf(v, __shfl_xor(v, o));
    return v;
}
__device__ __forceinline__ float sigmoidf_(float x) { return 1.f / (1.f + __expf(-x)); }
__device__ __forceinline__ float softplusf_(float x) { return fmaxf(x, 0.f) + log1pf(expf(-fabsf(x))); }
template <int CTRL> __device__ __forceinline__ float dpp_f(float x) { return __builtin_bit_cast(float, __builtin_amdgcn_update_dpp(0, __builtin_bit_cast(int, x), CTRL, 0xf, 0xf, false)); }
__device__ __forceinline__ float rowsum16(float x) { x += dpp_f<0x128>(x); x += dpp_f<0x124>(x); x += dpp_f<0x122>(x); x += dpp_f<0x121>(x); return x; }

namespace pg8 {
struct EpiSwiglu {
    static constexpr bool PERM = true, AFTER_DRAIN = false;
    bf16_t* H; int ldh;
    __device__ __forceinline__ void operator()(const f32x4 (&acc)[2][2][4][2], const Unit& u, int wr, int wc, int fr, int fq) const {
        const int row0 = u.pm * BM + wr * 64 + fr, col0 = u.pn * HALF + wc * 32 + 8 * fq;
#pragma unroll
        for (int ai = 0; ai < 2; ++ai)
#pragma unroll
            for (int m = 0; m < 4; ++m) {
                float hv[8];
#pragma unroll
                for (int n = 0; n < 2; ++n)
#pragma unroll
                    for (int j = 0; j < 4; ++j) { const float g = acc[ai][0][m][n][j], up = acc[ai][1][m][n][j];
                        hv[n * 4 + j] = g * __builtin_amdgcn_rcpf(1.0f + __builtin_amdgcn_exp2f(-1.4426950408889634f * g)) * up; }
                u32x4 w; w.x = cvt_pk_bf16(hv[0], hv[1]); w.y = cvt_pk_bf16(hv[2], hv[3]); w.z = cvt_pk_bf16(hv[4], hv[5]); w.w = cvt_pk_bf16(hv[6], hv[7]);
                *(u32x4*)(H + (size_t)(row0 + ai * HALF + m * 16) * ldh + col0) = w;
            }
    }
};
struct EpiRes {
    static constexpr bool PERM = false, AFTER_DRAIN = false;
    float* X; float ra, s;
    __device__ __forceinline__ void operator()(const f32x4 (&acc)[2][2][4][2], const Unit& u, int wr, int wc, int fr, int fq) const {
        const int row0 = u.pm * BM + wr * 64 + fr, col0 = u.pn * BM + wc * 32 + 4 * fq;
#pragma unroll
        for (int ai = 0; ai < 2; ++ai)
#pragma unroll
            for (int m = 0; m < 4; ++m) { float* rowp = X + (size_t)(row0 + ai * HALF + m * 16) * 1024 + col0;
#pragma unroll
                for (int bj = 0; bj < 2; ++bj)
#pragma unroll
                    for (int n = 0; n < 2; ++n) { f32x4* p = (f32x4*)(rowp + bj * HALF + n * 16); const f32x4 v = *p; *p = v * ra + acc[ai][bj][m][n] * s; } }
    }
};
}

struct TDesc { const float* src; bf16* dst; int K, N, mode, first; };
constexpr int NDESC = 24;
struct Args {
    const float* x; const float* mem; const float* ln_g; const float* ln_b;
    const float *mu, *w0, *a0, *k_k, *k_a, *r_k, *lnx_g, *lnx_b;
    float* out; unsigned char* ws;
    TDesc td[NDESC]; int nitems; int ph_lo, ph_hi, pad;
};

__device__ __forceinline__ void p0_transpose_item(const float* W, int K, int N, bf16* WT, int mode, LAS float* scr, int item, int lane) {
    const int nblk = N / 32, kb = item / nblk, nb = item % nblk, k0 = 64 * kb, n0 = 32 * nb;
#pragma unroll 8
    for (int i = 0; i < 32; ++i) { const int kk = 2 * i + (lane >> 5); scr[kk * 33 + (lane & 31)] = W[(size_t)(k0 + kk) * N + n0 + (lane & 31)]; }
    asm volatile("s_waitcnt lgkmcnt(0)" ::: "memory");
    const int c = lane & 7;
    const int rbase = mode == 0 ? n0 : (256 * (n0 >> 7) + (n0 & 127) + (mode == 2 ? 128 : 0));
#pragma unroll
    for (int j = 0; j < 4; ++j) { const int n = (lane >> 3) + 8 * j; const LAS float* s = scr + (8 * c) * 33 + n;
        u32x4 o; o.x = pk2(s[0 * 33], s[1 * 33]); o.y = pk2(s[2 * 33], s[3 * 33]); o.z = pk2(s[4 * 33], s[5 * 33]); o.w = pk2(s[6 * 33], s[7 * 33]);
        *(u32x4*)(WT + (size_t)(rbase + n) * K + k0 + 8 * c) = o; }
    asm volatile("s_waitcnt lgkmcnt(0)" ::: "memory");
}
__device__ __forceinline__ void p0_prologue(const Args& a, LAS unsigned char* lds, int gw, int ngw, int wave, int lane) {
    LAS float* scr = (LAS float*)(lds + wave * 16384);
    for (int it = gw; it < a.nitems; it += ngw) {
        int d = 0;
#pragma unroll 1
        for (int j = 1; j < NDESC; ++j) if (it >= a.td[j].first) d = j;
        p0_transpose_item(a.td[d].src, a.td[d].K, a.td[d].N, a.td[d].dst, a.td[d].mode, scr, it - a.td[d].first, lane);
    }
    bf16* xb = (bf16*)(a.ws + WS_XB); bf16* memb = (bf16*)(a.ws + WS_MEMB);
    for (int r = gw; r < M + NB * NMEM; r += ngw) {
        const bool isx = r < M; const int rr = isx ? r : r - M;
        const f32x4* s = (const f32x4*)((isx ? a.x : a.mem) + (size_t)rr * D) + lane;
        u32x2* o = (u32x2*)((isx ? xb : memb) + (size_t)rr * D) + lane;
#pragma unroll
        for (int j = 0; j < 4; ++j) { const f32x4 v = s[64 * j]; if (isx) ((f32x4*)(a.out + (size_t)rr * D))[lane + 64 * j] = v;
            u32x2 w; w.x = pk2(v[0], v[1]); w.y = pk2(v[2], v[3]); o[64 * j] = w; }
    }
}

__device__ __forceinline__ void ln_phase(const Args& a, unsigned char* ws, int li, int gw, int ngw, int lane) {
    const float* g = a.ln_g + (size_t)li * D; const float* b = a.ln_b + (size_t)li * D;
    bf16* xb = (bf16*)(ws + WS_XB);
    f32x4 gg[4], bb[4];
#pragma unroll
    for (int j = 0; j < 4; ++j) { gg[j] = ((const f32x4*)g)[lane + 64 * j]; bb[j] = ((const f32x4*)b)[lane + 64 * j]; }
    for (int row = gw; row < M; row += ngw) {
        f32x4* tr = (f32x4*)(a.out + (size_t)row * D) + lane;
        f32x4 v[4]; float s = 0.f;
#pragma unroll
        for (int j = 0; j < 4; ++j) { v[j] = tr[64 * j]; s += (v[j][0] + v[j][1]) + (v[j][2] + v[j][3]); }
        const float mean = wave_sum(s) * (1.f / D); float s2 = 0.f;
#pragma unroll
        for (int j = 0; j < 4; ++j) { v[j] = v[j] - mean; s2 += (v[j][0] * v[j][0] + v[j][1] * v[j][1]) + (v[j][2] * v[j][2] + v[j][3] * v[j][3]); }
        const float rstd = rsqrtf(wave_sum(s2) * (1.f / D) + LN_EPS);
        u32x2* o = (u32x2*)(xb + (size_t)row * D) + lane;
#pragma unroll
        for (int j = 0; j < 4; ++j) { const f32x4 y = v[j] * rstd * gg[j] + bb[j]; tr[64 * j] = y; u32x2 w; w.x = pk2(y[0], y[1]); w.y = pk2(y[2], y[3]); o[64 * j] = w; }
    }
}

typedef short v4i16_t __attribute__((ext_vector_type(4)));
__device__ __forceinline__ int crow(int r, int hi) { return (r & 3) + 8 * (r >> 2) + 4 * hi; }
__device__ __forceinline__ unsigned cvtpk(float lo, float hi) { typedef float f2 __attribute__((ext_vector_type(2))); typedef __bf16 b2 __attribute__((ext_vector_type(2))); f2 v = {lo, hi}; b2 b = __builtin_convertvector(v, b2); return __builtin_bit_cast(unsigned, b); }
__device__ __forceinline__ void at_load_k(bf16x8 (&kf)[8], const bf16* Kt, int ldk, int r32, int hi) {
#pragma unroll
    for (int kh = 0; kh < 2; ++kh)
#pragma unroll
        for (int d0 = 0; d0 < 4; ++d0) kf[kh * 4 + d0] = *(const bf16x8*)(Kt + (size_t)(32 * kh + r32) * ldk + 16 * d0 + 8 * hi);
}
__device__ __forceinline__ void at_load_v(u32x4 (&vr)[8], const bf16* Vt, int ldk, int lane) {
#pragma unroll
    for (int p = 0; p < 8; ++p) vr[p] = *(const u32x4*)(Vt + (size_t)(16 * (p & 3) + (lane >> 2)) * ldk + 32 * (p >> 2) + 8 * (lane & 3));
}
__device__ __forceinline__ void at_store_v(const u32x4 (&vr)[8], LAS unsigned char* vl, int lane) {
#pragma unroll
    for (int p = 0; p < 8; ++p) *(LAS u32x4*)(vl + p * 1024 + lane * 16) = vr[p];
}
__device__ __forceinline__ void at_qk(f32x16& p0, f32x16& p1, const bf16x8 (&kf)[8], const bf16x8 (&qr)[4]) {
    const f32x16 z = {0.f, 0.f, 0.f, 0.f, 0.f, 0.f, 0.f, 0.f, 0.f, 0.f, 0.f, 0.f, 0.f, 0.f, 0.f, 0.f};
    p0 = z; p1 = z;
#pragma unroll
    for (int d0 = 0; d0 < 4; ++d0) { p0 = __builtin_amdgcn_mfma_f32_32x32x16_bf16(kf[d0], qr[d0], p0, 0, 0, 0); p1 = __builtin_amdgcn_mfma_f32_32x32x16_bf16(kf[4 + d0], qr[d0], p1, 0, 0, 0); }
}
__device__ __forceinline__ void at_pv(f32x16 (&o)[2], const f32x16& a0, const f32x16& a1, const LAS unsigned char* vl, int lane) {
    const int hi = lane >> 5;
    const LAS unsigned char* vp = vl + ((lane >> 4) & 1) * 32 + (lane & 3) * 8 + (4 * hi + ((lane & 15) >> 2)) * 64;
    u32x4 pw[4];
    pw[0] = (u32x4){cvtpk(a0[0], a0[1]), cvtpk(a0[2], a0[3]), cvtpk(a0[4], a0[5]), cvtpk(a0[6], a0[7])};
    pw[1] = (u32x4){cvtpk(a0[8], a0[9]), cvtpk(a0[10], a0[11]), cvtpk(a0[12], a0[13]), cvtpk(a0[14], a0[15])};
    pw[2] = (u32x4){cvtpk(a1[0], a1[1]), cvtpk(a1[2], a1[3]), cvtpk(a1[4], a1[5]), cvtpk(a1[6], a1[7])};
    pw[3] = (u32x4){cvtpk(a1[8], a1[9]), cvtpk(a1[10], a1[11]), cvtpk(a1[12], a1[13]), cvtpk(a1[14], a1[15])};
#pragma unroll
    for (int dh = 0; dh < 2; ++dh)
#pragma unroll
        for (int kg = 0; kg < 4; ++kg) {
            const v4i16_t lo = __builtin_amdgcn_ds_read_tr16_b64_v4i16((LAS v4i16_t*)(vp + dh * 4096 + kg * 1024));
            const v4i16_t hh = __builtin_amdgcn_ds_read_tr16_b64_v4i16((LAS v4i16_t*)(vp + dh * 4096 + kg * 1024 + 512));
            const bf16x8 vf = {lo[0], lo[1], lo[2], lo[3], hh[0], hh[1], hh[2], hh[3]};
            o[dh] = __builtin_amdgcn_mfma_f32_32x32x16_bf16(__builtin_bit_cast(bf16x8, pw[kg]), vf, o[dh], 0, 0, 0);
        }
}
constexpr int AT_VL = 0, AT_WS = 65536;

__device__ __forceinline__ void memattn_phase(unsigned char* ws, LAS unsigned char* lds, int ldp, int mq_off, int gw, int ngw) {
    const bf16* proj = (const bf16*)(ws + WS_HP); const bf16* memkv = (const bf16*)(ws + WS_MEMKV); bf16* heads = (bf16*)(ws + WS_HEADS);
    int tid_l = threadIdx.x; asm volatile("" : "+v"(tid_l)); const int tid = tid_l, lane = tid & 63, wave = __builtin_amdgcn_readfirstlane(tid >> 6), r32 = lane & 31, hi = lane >> 5;
    LAS unsigned char* vl = lds + AT_VL + wave * 8192; LAS float* wsf = (LAS float*)(lds + AT_WS + wave * 256);
    for (int u = gw; u < NB * 4 * (SEQ / 32); u += ngw) {
        const int tg = u % (SEQ / 32), bh = u / (SEQ / 32), hm = bh & 3, b = bh >> 2;
        const bf16* Q = proj + ((size_t)b * SEQ + tg * 32) * ldp + mq_off + hm * 64;
        const bf16* K = memkv + (size_t)b * NMEM * 512 + hm * 64; const bf16* V = K + 256;
        bf16x8 qr[4];
#pragma unroll
        for (int d0 = 0; d0 < 4; ++d0) qr[d0] = *(const bf16x8*)(Q + (size_t)r32 * ldp + 16 * d0 + 8 * hi);
        bf16x8 kf[8]; f32x16 p0, p1;
        float mx = -3.0e38f;
#pragma unroll 1
        for (int t = 0; t < 4; ++t) {
            at_load_k(kf, K + (size_t)t * 64 * 512, 512, r32, hi); at_qk(p0, p1, kf, qr);
#pragma unroll
            for (int r = 0; r < 16; ++r) mx = fmaxf(mx, fmaxf(p0[r], p1[r]));
        }
        { auto rr = __builtin_amdgcn_permlane32_swap(__float_as_uint(mx), __float_as_uint(mx), false, false); mx = fmaxf(__uint_as_float(rr[0]), __uint_as_float(rr[1])); }
        const float c2 = 0.125f * 1.4426950408889634f; const float mc = mx * c2;
        f32x16 o[2]; o[0] = (f32x16){0.f, 0.f, 0.f, 0.f, 0.f, 0.f, 0.f, 0.f, 0.f, 0.f, 0.f, 0.f, 0.f, 0.f, 0.f, 0.f}; o[1] = o[0];
        float lsum = 0.f; u32x4 vr[8];
#pragma unroll 1
        for (int t = 0; t < 4; ++t) {
            at_load_k(kf, K + (size_t)t * 64 * 512, 512, r32, hi); at_load_v(vr, V + (size_t)t * 64 * 512, 512, lane);
            at_qk(p0, p1, kf, qr);
#pragma unroll
            for (int r = 0; r < 16; ++r) { p0[r] = __builtin_amdgcn_exp2f(p0[r] * c2 - mc); p1[r] = __builtin_amdgcn_exp2f(p1[r] * c2 - mc); lsum += p0[r] + p1[r]; }
            at_store_v(vr, vl, lane);
            at_pv(o, p0, p1, vl, lane);
        }
        { auto rr = __builtin_amdgcn_permlane32_swap(__float_as_uint(lsum), __float_as_uint(lsum), false, false); lsum = __uint_as_float(rr[0]) + __uint_as_float(rr[1]); }
        if (hi == 0) wsf[r32] = lsum;
        bf16* Ob = heads + ((size_t)b * SEQ + tg * 32) * D + C + hm * 64;
#pragma unroll
        for (int r = 0; r < 16; ++r) { const int q = crow(r, hi); const float inv = 1.f / wsf[q];
            Ob[(size_t)q * D + r32] = (bf16)f2bf(o[0][r] * inv); Ob[(size_t)q * D + 32 + r32] = (bf16)f2bf(o[1][r] * inv); }
    }
}

__device__ __forceinline__ void sb_phase(unsigned char* ws, LAS unsigned char* lds, int gw, int ngw) {
    const bf16* proj = (const bf16*)(ws + WS_HP); bf16* heads = (bf16*)(ws + WS_HEADS);
    int tid_l = threadIdx.x; asm volatile("" : "+v"(tid_l)); const int tid = tid_l, lane = tid & 63, wave = __builtin_amdgcn_readfirstlane(tid >> 6), r32 = lane & 31, hi = lane >> 5;
    LAS unsigned char* vl = lds + AT_VL + wave * 8192;
    for (int u = gw; u < NB * NH * (SEQ / 32); u += ngw) {
        const int bh = u % (NB * NH), rg = u / (NB * NH), b = bh / NH, h = bh % NH;
        const bf16* pb = proj + (size_t)b * SEQ * SB_IN + h * 64;
        const int R0 = rg * 32, tq = R0 + r32;
        bf16x8 qr[4];
#pragma unroll
        for (int d0 = 0; d0 < 4; ++d0) qr[d0] = *(const bf16x8*)(pb + (size_t)tq * SB_IN + 16 * d0 + 8 * hi);
        f32x16 o[2]; o[0] = (f32x16){0.f, 0.f, 0.f, 0.f, 0.f, 0.f, 0.f, 0.f, 0.f, 0.f, 0.f, 0.f, 0.f, 0.f, 0.f, 0.f}; o[1] = o[0];
        float carry = 1.f;
        bf16x8 kf[8]; u32x4 vr[8]; f32x16 p0, p1, k0, k1;
        int t = (R0 + 30) >> 6; if (R0 == 0) t = 0;
        at_load_k(kf, pb + C + (size_t)t * 64 * SB_IN, SB_IN, r32, hi); at_load_v(vr, pb + 2 * C + (size_t)t * 64 * SB_IN, SB_IN, lane);
#pragma unroll 1
        for (; t >= 0; --t) {
            at_qk(p0, p1, kf, qr);
            at_store_v(vr, vl, lane);
            if (t > 0) { at_load_k(kf, pb + C + (size_t)(t - 1) * 64 * SB_IN, SB_IN, r32, hi); at_load_v(vr, pb + 2 * C + (size_t)(t - 1) * 64 * SB_IN, SB_IN, lane); }
            const bool edge = (t * 64 + 63 >= R0);
#pragma unroll
            for (int r = 0; r < 16; ++r) {
                { const float z = p0[r], e = __builtin_amdgcn_exp2f(-fabsf(z) * (0.125f * 1.4426950408889634f)), rr = __builtin_amdgcn_rcpf(1.f + e), sm = e * rr;
                  float sg = z >= 0.f ? rr : sm, kp = z >= 0.f ? sm : rr;
                  if (edge) { const bool ok = (t * 64 + crow(r, hi)) < tq; sg = ok ? sg : 0.f; kp = ok ? kp : 1.f; }
                  p0[r] = sg; k0[r] = kp; }
                { const float z = p1[r], e = __builtin_amdgcn_exp2f(-fabsf(z) * (0.125f * 1.4426950408889634f)), rr = __builtin_amdgcn_rcpf(1.f + e), sm = e * rr;
                  float sg = z >= 0.f ? rr : sm, kp = z >= 0.f ? sm : rr;
                  if (edge) { const bool ok = (t * 64 + 32 + crow(r, hi)) < tq; sg = ok ? sg : 0.f; kp = ok ? kp : 1.f; }
                  p1[r] = sg; k1[r] = kp; }
            }
            float ge[8], go[8];
#pragma unroll
            for (int i = 0; i < 4; ++i) {
                const float g0 = (k0[4 * i] * k0[4 * i + 1]) * (k0[4 * i + 2] * k0[4 * i + 3]), g1 = (k1[4 * i] * k1[4 * i + 1]) * (k1[4 * i + 2] * k1[4 * i + 3]);
                auto ra = __builtin_amdgcn_permlane32_swap(__float_as_uint(g0), __float_as_uint(g0), false, false); ge[i] = __uint_as_float(ra[0]); go[i] = __uint_as_float(ra[1]);
                auto rb = __builtin_amdgcn_permlane32_swap(__float_as_uint(g1), __float_as_uint(g1), false, false); ge[4 + i] = __uint_as_float(rb[0]); go[4 + i] = __uint_as_float(rb[1]);
            }
            float X = carry, xo[8];
#pragma unroll
            for (int i = 7; i >= 0; --i) { const float xodd = X; X *= go[i]; const float xeven = X; X *= ge[i]; xo[i] = hi ? xodd : xeven; }
            carry = X;
#pragma unroll
            for (int i = 0; i < 4; ++i) {
                { float x = xo[i]; p0[4 * i + 3] *= x; x *= k0[4 * i + 3]; p0[4 * i + 2] *= x; x *= k0[4 * i + 2]; p0[4 * i + 1] *= x; x *= k0[4 * i + 1]; p0[4 * i] *= x; }
                { float x = xo[4 + i]; p1[4 * i + 3] *= x; x *= k1[4 * i + 3]; p1[4 * i + 2] *= x; x *= k1[4 * i + 2]; p1[4 * i + 1] *= x; x *= k1[4 * i + 1]; p1[4 * i] *= x; }
            }
            at_pv(o, p0, p1, vl, lane);
            if (__all(carry < 1e-30f)) break;
        }
        bf16* Ob = heads + ((size_t)b * SEQ + R0) * D + h * 64;
#pragma unroll
        for (int r = 0; r < 16; ++r) { const int q = crow(r, hi); Ob[(size_t)q * D + r32] = (bf16)f2bf(o[0][r]); Ob[(size_t)q * D + 32 + r32] = (bf16)f2bf(o[1][r]); }
    }
}

template <int KS> __device__ __forceinline__ void mma32(f32x16& acc, const LAS bf16* A, int lda, const LAS bf16* B, int ldb, int lane) {
    const int r = lane & 31, hh = lane >> 5;
#pragma unroll
    for (int ks = 0; ks < KS; ++ks) {
        const bf16x8 av = *(const LAS bf16x8*)(A + r * lda + ks * 16 + hh * 8);
        const bf16x8 bv = *(const LAS bf16x8*)(B + r * ldb + ks * 16 + hh * 8);
        acc = __builtin_amdgcn_mfma_f32_32x32x16_bf16(av, bv, acc, 0, 0, 0);
    }
}
constexpr int RK_CH = 32;
constexpr int RL_RZ = 0, RL_KZ = 8192, RL_VZ = 16384, RL_WL = 24576, RL_AL = 32768, RL_GG = 40960, RL_LO = 49152, RL_SV = 66048, RL_SC = 107008, RL_LW = 107520, RL_END = 143360;
constexpr int LO_LD = 264, LW_LD = 72, LG_LD = 136;
static_assert(RL_END <= LDS_BYTES, "rwkv lds");
__device__ __forceinline__ void rwkv_phase(const Args& a, unsigned char* ws, LAS unsigned char* lds, int unit) {
    int tid_l = threadIdx.x; asm volatile("" : "+v"(tid_l)); const int b = unit / NH, h = unit % NH, tid = tid_l, lane = tid & 63, wave = tid >> 6;
    const bf16* proj = (const bf16*)(ws + WS_HP) + (size_t)b * SEQ * RW_IN; bf16* heads = (bf16*)(ws + WS_HEADS) + (size_t)b * SEQ * D;
    LAS float* RZ = (LAS float*)(lds + RL_RZ); LAS float* KZ = (LAS float*)(lds + RL_KZ); LAS float* VZ = (LAS float*)(lds + RL_VZ);
    LAS float* WL = (LAS float*)(lds + RL_WL); LAS float* AL = (LAS float*)(lds + RL_AL); LAS float* GG = (LAS float*)(lds + RL_GG);
    LAS bf16* LO = (LAS bf16*)(lds + RL_LO); LAS float* SV = (LAS float*)(lds + RL_SV); LAS float* SC = (LAS float*)(lds + RL_SC);
    LAS bf16* LWw = (LAS bf16*)(lds + RL_LW); LAS bf16* LWa = LWw + 64 * LW_LD; LAS bf16* LWg = LWa + 64 * LW_LD;
    LAS float* OUT = KZ;
    { const bf16* gw_ = (const bf16*)(ws + WS_LW) + (size_t)h * 64 * 64; const bf16* ga_ = (const bf16*)(ws + WS_LW) + (size_t)768 * 64 + (size_t)h * 64 * 64;
      const bf16* gg_ = (const bf16*)(ws + WS_LW) + (size_t)768 * 128 + (size_t)h * 64 * 128;
      for (int i = tid; i < 64 * 64; i += NT) { const int n = i >> 6, k = i & 63; LWw[n * LW_LD + k] = gw_[i]; LWa[n * LW_LD + k] = ga_[i]; }
      for (int i = tid; i < 64 * 128; i += NT) { const int n = i >> 7, k = i & 127; LWg[n * LG_LD + k] = gg_[i]; } }
    const int cl = lane;
    const int ch = h * 64 + cl;
    const float c_w0 = a.w0[ch], c_a0 = a.a0[ch], c_kk = a.k_k[ch], c_ka = a.k_a[ch], c_rk = a.r_k[ch], c_lg = a.lnx_g[ch], c_lb = a.lnx_b[ch];
    const int jg = lane & 15, r0 = wave * 8 + (lane >> 4) * 2;
    f32x4 S0 = {0.f, 0.f, 0.f, 0.f}, S1 = {0.f, 0.f, 0.f, 0.f};
    __syncthreads();
    for (int t0 = 0; t0 < SEQ; t0 += RK_CH) {
        for (int i = tid; i < RK_CH * 448; i += NT) {
            const int tt = i / 448, cc = i % 448, t = t0 + tt;
            int col, mcol;
            if (cc < 192) { const int which = cc >> 6; col = which * C + h * 64 + (cc & 63); } else col = 3 * C + (cc - 192);
            mcol = col;
            const float cur = bf2f(proj[(size_t)t * RW_IN + col]); const float prev = t > 0 ? bf2f(proj[(size_t)(t - 1) * RW_IN + col]) : 0.f;
            const float z = cur + (prev - cur) * a.mu[mcol];
            if (cc < 64) RZ[tt * 64 + cc] = z; else if (cc < 128) KZ[tt * 64 + (cc - 64)] = z; else if (cc < 192) VZ[tt * 64 + (cc - 128)] = z;
            else { const int l = cc - 192; const float v = l < 64 ? tanhf(z) : (l < 128 ? z : sigmoidf_(z)); LO[tt * LO_LD + l] = (bf16)f2bf(v); }
        }
        __syncthreads();
        if (wave < 6) {
            const int mat = wave >> 1, nt = wave & 1;
            f32x16 acc = {0.f, 0.f, 0.f, 0.f, 0.f, 0.f, 0.f, 0.f, 0.f, 0.f, 0.f, 0.f, 0.f, 0.f, 0.f, 0.f};
            if (mat == 0) mma32<4>(acc, LO, LO_LD, LWw + nt * 32 * LW_LD, LW_LD, lane);
            else if (mat == 1) mma32<4>(acc, LO + 64, LO_LD, LWa + nt * 32 * LW_LD, LW_LD, lane);
            else mma32<8>(acc, LO + 128, LO_LD, LWg + nt * 32 * LG_LD, LG_LD, lane);
            LAS float* dst = mat == 0 ? WL : (mat == 1 ? AL : GG);
#pragma unroll
            for (int r = 0; r < 16; ++r) { const int tok = (r & 3) + 8 * (r >> 2) + 4 * (lane >> 5); dst[tok * 64 + nt * 32 + (lane & 31)] = acc[r]; }
        }
        __syncthreads();
#pragma unroll 1
        for (int q = 0; q < 4; ++q) {
            const int tt = wave * 4 + q;
            const float wl = c_w0 + WL[tt * 64 + cl], al = c_a0 + AL[tt * 64 + cl];
            const float wlog = -softplusf_(-wl) - 0.5f, w = __expf(-__expf(wlog)), aa = sigmoidf_(al);
            const float r = RZ[tt * 64 + cl], kraw = KZ[tt * 64 + cl];
            const float kkr = kraw * c_kk, ss = wave_sum(kkr * kkr), kkn = kkr * rsqrtf(fmaxf(ss, 1e-24f));
            const float k = kraw * (1.f + (aa - 1.f) * c_ka), bb = kkn * aa;
            const float br = wave_sum(bb * r), kr = wave_sum(k * r), bon = wave_sum(r * k * c_rk);
            LAS float* sv = SV + tt * 320;
            sv[cl] = kkn; sv[64 + cl] = w * r; sv[128 + cl] = w; sv[192 + cl] = bb; sv[256 + cl] = k;
            if (lane == 0) { SC[tt * 4 + 0] = br; SC[tt * 4 + 1] = kr; SC[tt * 4 + 2] = bon; }
        }
        __syncthreads();
#pragma unroll 2
        for (int tt = 0; tt < RK_CH; ++tt) {
            const LAS float* sv = SV + tt * 320 + 4 * jg;
            const f32x4 k4 = *(const LAS f32x4*)(sv), r4 = *(const LAS f32x4*)(sv + 64), w4 = *(const LAS f32x4*)(sv + 128), b4 = *(const LAS f32x4*)(sv + 192), q4 = *(const LAS f32x4*)(sv + 256);
            const float v0 = VZ[tt * 64 + r0], v1 = VZ[tt * 64 + r0 + 1], br = SC[tt * 4 + 0], kr = SC[tt * 4 + 1];
            float sa0 = (S0[0] * k4[0] + S0[1] * k4[1]) + (S0[2] * k4[2] + S0[3] * k4[3]);
            float p0 = (S0[0] * r4[0] + S0[1] * r4[1]) + (S0[2] * r4[2] + S0[3] * r4[3]);
            float sa1 = (S1[0] * k4[0] + S1[1] * k4[1]) + (S1[2] * k4[2] + S1[3] * k4[3]);
            float p1 = (S1[0] * r4[0] + S1[1] * r4[1]) + (S1[2] * r4[2] + S1[3] * r4[3]);
            sa0 = rowsum16(sa0); p0 = rowsum16(p0); sa1 = rowsum16(sa1); p1 = rowsum16(p1);
            if (jg == 0) { OUT[tt * 64 + r0] = p0 - sa0 * br + v0 * kr; OUT[tt * 64 + r0 + 1] = p1 - sa1 * br + v1 * kr; }
            S0 = S0 * w4 - b4 * sa0 + q4 * v0;
            S1 = S1 * w4 - b4 * sa1 + q4 * v1;
        }
        __syncthreads();
#pragma unroll 1
        for (int q = 0; q < 4; ++q) {
            const int tt = wave * 4 + q;
            const float o = OUT[tt * 64 + cl];
            const float m = wave_sum(o) * (1.f / 64.f), d = o - m, var = wave_sum(d * d) * (1.f / 64.f);
            const float y = d * rsqrtf(var + LNX_EPS) * c_lg + c_lb;
            const float res = (y + SC[tt * 4 + 2] * VZ[tt * 64 + cl]) * GG[tt * 64 + cl];
            heads[(size_t)(t0 + tt) * D + ch] = (bf16)f2bf(res);
        }
        __syncthreads();
    }
}

__global__ void __launch_bounds__(NT, 2) mega(Args a) {
    extern __shared__ __attribute__((aligned(16))) unsigned char lds_raw[];
    LAS unsigned char* lds = (LAS unsigned char*)lds_raw;
    cg::grid_group grid = cg::this_grid();
    const bool coop = (a.ph_hi - a.ph_lo) > 1;
#pragma unroll 1
    for (int ph = a.ph_lo; ph < a.ph_hi; ++ph) {
        int p = ph; asm volatile("" : "+s"(p));
        unsigned char* ws = a.ws; asm volatile("" : "+s"(ws));
        int tid_l = threadIdx.x; asm volatile("" : "+v"(tid_l));
        const int tid = tid_l, lane = tid & 63, wave = __builtin_amdgcn_readfirstlane(tid >> 6);
        const int G = gridDim.x, wg = blockIdx.x, gw = wg * NWAVES + wave, ngw = G * NWAVES;
        bf16* xb = (bf16*)(ws + WS_XB); bf16* hp = (bf16*)(ws + WS_HP); bf16* heads = (bf16*)(ws + WS_HEADS);
        if (p == 0) { p0_prologue(a, lds, gw, ngw, wave, lane); __syncthreads(); }
        else {
            const int L = (p - 1) / 10, sub = (p - 1) % 10;
            if (sub == 0 || sub == 7) {
                const int fi = L * 2 + (sub == 7 ? 1 : 0);
                { pg8::Gemm g{xb, (const bf16*)(ws + WS_WGU) + (size_t)fi * 2 * FF * D, M, 2 * FF, D}; pg8::StaticOrder S; S.init(M, 2 * FF, G, wg);
                  pg8::EpiSwiglu E{hp, FF};
                  pg8::gemm_phase<pg8::EpiSwiglu, pg8::StaticOrder, true, true>(lds, g, S, E); }
            } else if (sub == 1 || sub == 8) {
                const int fi = L * 2 + (sub == 8 ? 1 : 0);
                pg8::Gemm g{hp, (const bf16*)(ws + WS_WD) + (size_t)fi * FF * D, M, D, FF}; pg8::StaticOrder S; S.init(M, D, G, wg);
                pg8::EpiRes E{a.out, ALPHA, 0.5f};
                pg8::gemm_phase<pg8::EpiRes, pg8::StaticOrder, true, true>(lds, g, S, E);
            } else if (sub == 5) {
                pg8::Gemm g{heads, (const bf16*)(ws + WS_WOUT) + (size_t)L * D * D, M, D, D}; pg8::StaticOrder S; S.init(M, D, G, wg);
                pg8::EpiRes E{a.out, ALPHA, 1.0f};
                pg8::gemm_phase<pg8::EpiRes, pg8::StaticOrder, true, true>(lds, g, S, E);
            } else if (sub == 2 || sub == 6 || sub == 9) {
                ln_phase(a, ws, L * 3 + (sub == 2 ? 0 : (sub == 6 ? 1 : 2)), gw, ngw, lane);
            } else if (sub == 3) {
                const int nrep = L == 0 ? 2 : 1;
#pragma unroll 1
                for (int rep = 0; rep < nrep; ++rep) {
                    int rp = rep; asm volatile("" : "+s"(rp));
                    const int N = rp == 1 ? 512 : (L == 0 ? RW_IN : SB_IN), Mr = rp == 1 ? NB * NMEM : M;
                    pg8::Gemm g{rp == 1 ? (const bf16*)(ws + WS_MEMB) : xb, (const bf16*)(ws + (rp == 1 ? WS_WMKV : (L == 0 ? WS_WIN0 : WS_WIN1))), Mr, N, D}; pg8::StaticOrder S; S.init(Mr, N, G, wg);
                    pg8::EpiBf16<0> E{rp == 1 ? (bf16*)(ws + WS_MEMKV) : hp, N, nullptr, 0, 0, 1.f};
                    pg8::gemm_phase<pg8::EpiBf16<0>, pg8::StaticOrder, true, true>(lds, g, S, E);
                }
            } else {
                if (L == 0) {
                    if (wg < NB * NH) rwkv_phase(a, ws, lds, wg);
                    else memattn_phase(ws, lds, RW_IN, RW_SHIFT, (wg - NB * NH) * NWAVES + wave, (G - NB * NH) * NWAVES);
                } else {
                    sb_phase(ws, lds, gw, ngw);
                    memattn_phase(ws, lds, SB_IN, 3 * C, gw, ngw);
                }
            }
        }
        if (coop && ph + 1 < a.ph_hi) grid.sync();
    }
}
constexpr int NPHASES = 1 + 2 * (3 + 4 + 3);

extern "C" void kernel_launch(void* const* d_in, const int* in_sizes, int n_in, void* d_out, int out_size, void* d_ws, size_t ws_size, hipStream_t stream) {
    static int grid = 0;
    if (grid == 0) {
        if (n_in != 25 || out_size != M * D || ws_size < WS_END) { fprintf(stderr, "kernel_launch: unexpected shapes (n_in %d out %d ws %zu)\n", n_in, out_size, ws_size); grid = -1; return; }
        int dev = 0, cus = 0, per_cu = 0;
        (void)hipGetDevice(&dev); (void)hipDeviceGetAttribute(&cus, hipDeviceAttributeMultiprocessorCount, dev);
        if (hipFuncSetAttribute((const void*)mega, hipFuncAttributeMaxDynamicSharedMemorySize, LDS_BYTES) != hipSuccess) { fprintf(stderr, "kernel_launch: hipFuncSetAttribute failed\n"); grid = -1; return; }
        if (hipOccupancyMaxActiveBlocksPerMultiprocessor(&per_cu, (const void*)mega, NT, LDS_BYTES) != hipSuccess || per_cu < 1) { fprintf(stderr, "kernel_launch: occupancy query failed (%d)\n", per_cu); per_cu = 1; }
        (void)hipGetLastError();
        grid = cus;
        fprintf(stderr, "kernel_launch: cus %d per_cu %d grid %d\n", cus, per_cu, grid);
    }
    if (grid < 0) return;
    Args a{};
    const float* const* in = (const float* const*)d_in;
    a.x = in[0]; a.mem = in[1]; a.ln_g = in[8]; a.ln_b = in[9];
    a.mu = in[13]; a.w0 = in[14]; a.a0 = in[16]; a.k_k = in[19]; a.k_a = in[20]; a.r_k = in[21]; a.lnx_g = in[22]; a.lnx_b = in[23];
    a.out = (float*)d_out; a.ws = (unsigned char*)d_ws;
    unsigned char* ws = (unsigned char*)d_ws;
    int nd = 0, first = 0;
    auto add = [&](const float* src, bf16* dst, int K, int N, int mode) { a.td[nd] = TDesc{src, dst, K, N, mode, first}; first += (K / 64) * (N / 32); ++nd; };
    for (int layer = 0; layer < 2; ++layer)
        for (int f = 0; f < 2; ++f) {
            const int fi = layer * 2 + f; bf16* gu = (bf16*)(ws + WS_WGU) + (size_t)fi * 2 * FF * D;
            add(in[f == 0 ? 2 : 5] + (size_t)layer * D * FF, gu, D, FF, 1);
            add(in[f == 0 ? 3 : 6] + (size_t)layer * D * FF, gu, D, FF, 2);
            add(in[f == 0 ? 4 : 7] + (size_t)layer * FF * D, (bf16*)(ws + WS_WD) + (size_t)fi * FF * D, FF, D, 0);
        }
    add(in[12], (bf16*)(ws + WS_WIN0), D, RW_IN, 0);
    add(in[24], (bf16*)(ws + WS_WIN1), D, SB_IN, 0);
    add(in[10], (bf16*)(ws + WS_WOUT), D, D, 0);
    add(in[10] + (size_t)D * D, (bf16*)(ws + WS_WOUT) + (size_t)D * D, D, D, 0);
    add(in[11], (bf16*)(ws + WS_WMKV), D, 512, 0);
    add(in[15], (bf16*)(ws + WS_LW), 64, C, 0);
    add(in[17], (bf16*)(ws + WS_LW) + (size_t)768 * 64, 64, C, 0);
    add(in[18], (bf16*)(ws + WS_LW) + (size_t)768 * 128, 128, C, 0);
    for (; nd < NDESC; ++nd) a.td[nd] = TDesc{nullptr, nullptr, 64, 32, 0, 0x7fffffff};
    a.nitems = first;
#ifndef MK_SPLIT
    a.ph_lo = 0; a.ph_hi = NPHASES;
    void* args[] = {&a};
    hipError_t e = hipLaunchCooperativeKernel((const void*)mega, dim3(grid), dim3(NT), args, LDS_BYTES, stream);
    if (e != hipSuccess) fprintf(stderr, "cooperative launch failed: %s (grid %d)\n", hipGetErrorString(e), grid);
#else
    for (int p = 0; p < NPHASES; ++p) { a.ph_lo = p; a.ph_hi = p + 1; hipLaunchKernelGGL(mega, dim3(grid), dim3(NT), LDS_BYTES, stream, a); }
#endif
}
```

```cpp
#include <hip/hip_runtime.h>
#include <hip/hip_cooperative_groups.h>
#include <cstdio>
#include <cstdint>
namespace cg = cooperative_groups;
namespace pg8 {
#define PG8_LAS __attribute__((address_space(3)))
typedef unsigned short bf16_t;
typedef short bf16x8 __attribute__((ext_vector_type(8)));
typedef float f32x4 __attribute__((ext_vector_type(4)));
typedef unsigned u32x4 __attribute__((ext_vector_type(4)));
constexpr int BM = 256, BK = 64, HALF = 128, HTB = HALF * BK * 2  , STAGE_BYTES = 8 * HTB, NXCD = 8, WGM = 8;

__host__ __device__ __forceinline__ int lds_byte(int r, int c) { const int st = (r >> 4) * 2 + (c >> 5), rr = r & 15, cc = c & 31, ob = rr * 64 + cc * 2; return st * 1024 + (ob ^ (((ob >> 9) & 1) << 5)); }
__host__ __device__ __forceinline__ void stage_rc(int b, int& R, int& C) { const int st = b / 1024, sb = b % 1024, swz = sb ^ (((sb >> 9) & 1) << 5); R = (st >> 1) * 16 + swz / 64; C = (st & 1) * 32 + (swz % 64) / 2; }
__host__ __device__ __forceinline__ int perm32(int rho) { const int n = rho >> 4, i = rho & 15; return 8 * (i >> 2) + 4 * n + (i & 3); }

struct Unit { int pm, pn; };
struct Gemm { const bf16_t* A; const bf16_t* Bt; int M, N, K; };

struct StaticOrder {
    int nM, nN, nwg, G, c;
    __host__ __device__ void init(int M, int N, int G_, int c_) { nM = M / BM; nN = N / BM; nwg = nM * nN; G = G_; c = c_; }
    __host__ __device__ bool next(int i, Unit& u) const {
        const long L = (long)i * G + c; if (L >= nwg) return false;
        int wgid = (int)L; { const int q = nwg / NXCD, r = nwg % NXCD, xcd = wgid % NXCD, off = wgid / NXCD; wgid = (xcd < r ? xcd * (q + 1) : r * (q + 1) + (xcd - r) * q) + off; }
        const int nig = WGM * nN, gid = wgid / nig, fm = gid * WGM, gsz = (nM - fm) < WGM ? (nM - fm) : WGM;
        u.pm = fm + ((wgid % nig) % gsz); u.pn = (wgid % nig) / gsz; return true;
    }
    __device__ __forceinline__ void a_ready(const Unit&) const {}
    __device__ __forceinline__ void done(const Unit&) const {}
};

__device__ __forceinline__ unsigned cvt_pk_bf16(float lo, float hi) { unsigned r; asm volatile("v_cvt_pk_bf16_f32 %0, %1, %2" : "=v"(r) : "v"(lo), "v"(hi)); return r; }
typedef float f32x2 __attribute__((ext_vector_type(2)));
__device__ __forceinline__ f32x2 gelu_pk(f32x2 v) {
    const f32x2 av = __builtin_elementwise_abs(v), d = av * 0.2316418882f + 1.0f;
    f32x2 t; t.x = __builtin_amdgcn_rcpf(d.x); t.y = __builtin_amdgcn_rcpf(d.y);
    f32x2 q = t * 0.5307027145f + (-0.7265760135f); q = q * t + 0.7107068705f; q = q * t + (-0.142248368f); q = q * t + 0.127414796f; q = q * t;
    const f32x2 s = (v * v) * (-0.72134752044f);
    f32x2 e; e.x = __builtin_amdgcn_exp2f(s.x); e.y = __builtin_amdgcn_exp2f(s.y);
    const f32x2 m = v * (q * e), r = v - m;
    f32x2 o; o.x = v.x < 0.f ? m.x : r.x; o.y = v.y < 0.f ? m.y : r.y; return o;
}

template <int ACT  > struct EpiBf16 {
    static constexpr bool PERM = true, AFTER_DRAIN = false; static_assert(ACT == 0 || ACT == 1, "EpiBf16: ACT is 0 (none) or 1 (gelu_pk)");
    bf16_t* O; int ldc; const float* bias; int split_cols; size_t split_stride; float scale0;
    __device__ __forceinline__ void operator()(const f32x4 (&acc)[2][2][4][2], const Unit& u, int wr, int wc, int fr, int fq) const {
        const int row0 = u.pm * BM + wr * 64 + fr; int colt = u.pn * BM; bf16_t* base = O;
        float sc = 1.f; if (split_cols) { const int t = colt / split_cols; base += (size_t)t * split_stride; colt -= t * split_cols; if (t == 0) sc = scale0; }
        const int col0 = colt + wc * 32 + 8 * fq, bcol0 = u.pn * BM + wc * 32 + 8 * fq;
        f32x4 bv[2][2];
#pragma unroll
        for (int bj = 0; bj < 2; ++bj)
#pragma unroll
            for (int n = 0; n < 2; ++n) bv[bj][n] = bias ? *(const f32x4*)(bias + bcol0 + bj * HALF + 4 * n) : (f32x4){0.f, 0.f, 0.f, 0.f};
#pragma unroll
        for (int ai = 0; ai < 2; ++ai)
#pragma unroll
            for (int m = 0; m < 4; ++m) { bf16_t* rowp = base + (size_t)(row0 + ai * HALF + m * 16) * ldc + col0;
#pragma unroll
                for (int bj = 0; bj < 2; ++bj) { f32x4 v0 = acc[ai][bj][m][0] + bv[bj][0], v1 = acc[ai][bj][m][1] + bv[bj][1];
                    if (ACT == 1) { f32x2 a = gelu_pk((f32x2){v0[0], v0[1]}), b = gelu_pk((f32x2){v0[2], v0[3]}), c = gelu_pk((f32x2){v1[0], v1[1]}), d = gelu_pk((f32x2){v1[2], v1[3]});
                        v0 = (f32x4){a.x, a.y, b.x, b.y}; v1 = (f32x4){c.x, c.y, d.x, d.y}; }
                    v0 = v0 * sc; v1 = v1 * sc; u32x4 w; w.x = cvt_pk_bf16(v0[0], v0[1]); w.y = cvt_pk_bf16(v0[2], v0[3]); w.z = cvt_pk_bf16(v1[0], v1[1]); w.w = cvt_pk_bf16(v1[2], v1[3]);
                    *(u32x4*)(rowp + bj * HALF) = w; } }
    }
};

template <class Epi, class Sched, bool ALIGN_EPI = false, bool SP2 = false>
__device__ __forceinline__ void gemm_phase(PG8_LAS unsigned char* lds, const Gemm g, const Sched& S, const Epi& E) {
    int tid_l = threadIdx.x; asm volatile("" : "+v"(tid_l));
    const int tid = tid_l, wid = __builtin_amdgcn_readfirstlane(tid >> 6), lane = tid & 63, wr = wid >> 2, wc = wid & 3, fr = lane & 15, fq = lane >> 4;
    const int K = g.K, nt = K / BK;
    unsigned voffA[2], voffB[2];
#pragma unroll
    for (int i = 0; i < 2; ++i) { int R, C; stage_rc(tid * 16 + i * 8192, R, C); const int Rb = Epi::PERM ? ((R & ~31) + perm32(R & 31)) : R;
        voffA[i] = (unsigned)(R * K + C) * 2u; voffB[i] = (unsigned)(Rb * K + C) * 2u; }
    const size_t kstep = (size_t)(BK * 2);
    const size_t hstep = (size_t)HALF * K * 2;
    const size_t tstep = 2 * hstep;
    const unsigned ldsw = (unsigned)wid * 1024u;
    const int aoff = lds_byte(wr * 64 + fr, fq * 8), boff = lds_byte(wc * 32 + fr, fq * 8);
#define PG8_SA(b, h) (((b) * 2 + (h)) * HTB)
#define PG8_SB(b, h) ((4 + (b) * 2 + (h)) * HTB)
#define PG8_STAGE(bufoff, gbase, voff) do { _Pragma("unroll") for (int _i = 0; _i < 2; ++_i) \
        __builtin_amdgcn_global_load_lds((const unsigned*)((const char*)(gbase) + (voff)[_i]), (PG8_LAS unsigned*)(lds + (bufoff) + ldsw + _i * 8192), 16, 0, 0); } while (0)
#define PG8_LDA(dst, b, h) do { _Pragma("unroll") for (int m = 0; m < 4; ++m) _Pragma("unroll") for (int k = 0; k < 2; ++k) dst[m][k] = *(const PG8_LAS bf16x8*)(lds + PG8_SA(b, h) + aoff + m * 2048 + k * 1024); } while (0)
#define PG8_LDB(dst, b, h) do { _Pragma("unroll") for (int n = 0; n < 2; ++n) _Pragma("unroll") for (int k = 0; k < 2; ++k) dst[n][k] = *(const PG8_LAS bf16x8*)(lds + PG8_SB(b, h) + boff + n * 2048 + k * 1024); } while (0)
#define PG8_MMA(ai, bj, At, Bt) do { __builtin_amdgcn_s_setprio(1); _Pragma("unroll") for (int m = 0; m < 4; ++m) _Pragma("unroll") for (int n = 0; n < 2; ++n) _Pragma("unroll") for (int k = 0; k < 2; ++k) \
        acc[ai][bj][m][n] = __builtin_amdgcn_mfma_f32_16x16x32_bf16(Bt[n][k], At[m][k], acc[ai][bj][m][n], 0, 0, 0); __builtin_amdgcn_s_setprio(0); } while (0)
#define PG8_WAIT_V(n) asm volatile("s_waitcnt vmcnt(" #n ")" ::: "memory")
#define PG8_WAIT_L(n) asm volatile("s_waitcnt lgkmcnt(" #n ")" ::: "memory")
#define PG8_BAR __builtin_amdgcn_s_barrier()
#define PG8_SCHED __builtin_amdgcn_sched_barrier(0)
    Unit cur, nxt; int ui = 0;
    if (!S.next(0, cur)) return;
    f32x4 acc[2][2][4][2];
#pragma unroll
    for (int a = 0; a < 2; ++a)
#pragma unroll
        for (int b = 0; b < 2; ++b)
#pragma unroll
            for (int m = 0; m < 4; ++m)
#pragma unroll
                for (int n = 0; n < 2; ++n) acc[a][b][m][n] = (f32x4){0.f, 0.f, 0.f, 0.f};
    bf16x8 At[4][2], B0[2][2], B1[2][2];
    const char* cA = (const char*)g.A + (size_t)cur.pm * tstep; const char* cB = (const char*)g.Bt + (size_t)cur.pn * tstep;
    S.a_ready(cur);
    if constexpr (SP2) {
        PG8_STAGE(PG8_SB(0, 0), cB, voffB); PG8_STAGE(PG8_SB(0, 1), cB + hstep, voffB); PG8_STAGE(PG8_SA(0, 0), cA, voffA); PG8_STAGE(PG8_SA(0, 1), cA + hstep, voffA);
        if (wr == 1) PG8_BAR;
        PG8_WAIT_V(2); PG8_BAR;
        PG8_STAGE(PG8_SB(1, 0), cB + kstep, voffB); PG8_STAGE(PG8_SA(1, 0), cA + kstep, voffA); PG8_STAGE(PG8_SB(1, 1), cB + hstep + kstep, voffB);
        PG8_WAIT_V(6); PG8_BAR;
    } else {
        PG8_STAGE(PG8_SB(0, 0), cB, voffB); PG8_STAGE(PG8_SA(0, 0), cA, voffA); PG8_STAGE(PG8_SB(0, 1), cB + hstep, voffB); PG8_STAGE(PG8_SA(0, 1), cA + hstep, voffA);
        if (wr == 1) PG8_BAR;
        PG8_WAIT_V(4); PG8_BAR;
        PG8_STAGE(PG8_SB(1, 0), cB + kstep, voffB); PG8_STAGE(PG8_SA(1, 0), cA + kstep, voffA); PG8_STAGE(PG8_SB(1, 1), cB + hstep + kstep, voffB);
        PG8_WAIT_V(6); PG8_BAR;
    }
    for (;;) {
        const bool has_next = S.next(ui + 1, nxt);
        const char* nA = has_next ? (const char*)g.A + (size_t)nxt.pm * tstep : cA; const char* nB = has_next ? (const char*)g.Bt + (size_t)nxt.pn * tstep : cB;
        for (int t = 0; t < nt; t += 2) {
            const bool last = (t == nt - 2);
            const char* a1 = cA + (size_t)(t + 1) * kstep;
            const char* a2 = last ? nA : cA + (size_t)(t + 2) * kstep; const char* b2 = last ? nB : cB + (size_t)(t + 2) * kstep;
            const char* a3 = a2 + kstep; const char* b3 = b2 + kstep;
            if (last && has_next) S.a_ready(nxt);
            if constexpr (SP2) {
            PG8_LDB(B0, 0, 0); PG8_LDB(B1, 0, 1); PG8_SCHED; PG8_LDA(At, 0, 0); PG8_STAGE(PG8_SA(1, 1), a1 + hstep, voffA);
            PG8_WAIT_V(8); PG8_WAIT_L(0); PG8_BAR; PG8_MMA(0, 0, At, B0); PG8_MMA(0, 1, At, B1); PG8_BAR; PG8_SCHED;
            PG8_LDA(At, 0, 1); PG8_STAGE(PG8_SB(0, 0), b2, voffB); PG8_STAGE(PG8_SB(0, 1), b2 + hstep, voffB); PG8_STAGE(PG8_SA(0, 0), a2, voffA);
            PG8_WAIT_V(8); PG8_WAIT_L(0); PG8_BAR; PG8_MMA(1, 0, At, B0); PG8_MMA(1, 1, At, B1); PG8_BAR; PG8_SCHED;
            PG8_LDB(B0, 1, 0); PG8_LDB(B1, 1, 1); PG8_SCHED; PG8_LDA(At, 1, 0); PG8_STAGE(PG8_SA(0, 1), a2 + hstep, voffA);
            PG8_WAIT_V(8); PG8_WAIT_L(0); PG8_BAR; PG8_MMA(0, 0, At, B0); PG8_MMA(0, 1, At, B1); PG8_BAR; PG8_SCHED;
            PG8_LDA(At, 1, 1); PG8_STAGE(PG8_SB(1, 0), b3, voffB); PG8_STAGE(PG8_SB(1, 1), b3 + hstep, voffB); PG8_STAGE(PG8_SA(1, 0), a3, voffA);
            PG8_WAIT_V(8); PG8_WAIT_L(0); PG8_BAR; PG8_MMA(1, 0, At, B0); PG8_MMA(1, 1, At, B1); PG8_BAR; PG8_SCHED;
            } else {
            PG8_LDB(B0, 0, 0); PG8_SCHED; PG8_LDA(At, 0, 0); PG8_STAGE(PG8_SA(1, 1), a1 + hstep, voffA);
            PG8_WAIT_L(8); PG8_BAR; PG8_WAIT_L(0); PG8_MMA(0, 0, At, B0); PG8_BAR; PG8_SCHED;
            PG8_LDB(B1, 0, 1); PG8_STAGE(PG8_SB(0, 0), b2, voffB);
            PG8_BAR; PG8_WAIT_L(0); PG8_MMA(0, 1, At, B1); PG8_BAR;
            PG8_LDA(At, 0, 1); PG8_STAGE(PG8_SA(0, 0), a2, voffA);
            PG8_BAR; PG8_WAIT_L(0); PG8_MMA(1, 0, At, B0); PG8_BAR; PG8_SCHED;
            PG8_STAGE(PG8_SB(0, 1), b2 + hstep, voffB);
            PG8_WAIT_V(6); PG8_BAR; PG8_MMA(1, 1, At, B1); PG8_BAR;
            PG8_LDB(B0, 1, 0); PG8_SCHED; PG8_LDA(At, 1, 0); PG8_STAGE(PG8_SA(0, 1), a2 + hstep, voffA);
            PG8_WAIT_L(8); PG8_BAR; PG8_WAIT_L(0); PG8_MMA(0, 0, At, B0); PG8_BAR; PG8_SCHED;
            PG8_LDB(B1, 1, 1); PG8_STAGE(PG8_SB(1, 0), b3, voffB);
            PG8_BAR; PG8_WAIT_L(0); PG8_MMA(0, 1, At, B1); PG8_BAR;
            PG8_LDA(At, 1, 1); PG8_STAGE(PG8_SA(1, 0), a3, voffA);
            PG8_BAR; PG8_WAIT_L(0); PG8_MMA(1, 0, At, B0); PG8_BAR; PG8_SCHED;
            PG8_STAGE(PG8_SB(1, 1), b3 + hstep, voffB);
            PG8_WAIT_V(6); PG8_BAR; PG8_MMA(1, 1, At, B1); PG8_BAR;
            }
        }
        if constexpr (ALIGN_EPI) { if (wr == 0) PG8_BAR; }
        if constexpr (!Epi::AFTER_DRAIN) { E(acc, cur, wr, wc, fr, fq); S.done(cur); }
        if (!has_next) break;
#pragma unroll
        for (int a = 0; a < 2; ++a)
#pragma unroll
            for (int b = 0; b < 2; ++b)
#pragma unroll
                for (int m = 0; m < 4; ++m)
#pragma unroll
                    for (int n = 0; n < 2; ++n) acc[a][b][m][n] = (f32x4){0.f, 0.f, 0.f, 0.f};
        cur = nxt; cA = nA; cB = nB; ++ui;
        if constexpr (ALIGN_EPI) { if (wr == 1) PG8_BAR; }
    }
    PG8_WAIT_V(0);
    if constexpr (!ALIGN_EPI) { if (wr == 0) PG8_BAR; }
    PG8_BAR;
    if constexpr (Epi::AFTER_DRAIN) { E.fused(acc, cur, wr, wc, fr, fq, lds, wid, lane); S.done(cur); }
#undef PG8_SA
#undef PG8_SB
#undef PG8_STAGE
#undef PG8_LDA
#undef PG8_LDB
#undef PG8_MMA
#undef PG8_WAIT_V
#undef PG8_WAIT_L
#undef PG8_BAR
#undef PG8_SCHED
}
}

constexpr int D = 1024, NB = 8, SEQ = 2048, M = NB * SEQ, NMEM = 256;
constexpr int C = 768, NH = 12, FF = 2816;
constexpr int RW_SHIFT = 2560, RW_IN = 2816, SB_IN = 2560;
constexpr float ALPHA = 1.41421356237309515f;
constexpr float LN_EPS = 1e-5f, LNX_EPS = 64e-5f;
constexpr int NWAVES = 8, NT = 512;
constexpr int LDS_BYTES = 159744;

#define LAS __attribute__((address_space(3)))
typedef unsigned short bf16;
typedef float f32x4 __attribute__((ext_vector_type(4)));
typedef float f32x16 __attribute__((ext_vector_type(16)));
typedef short bf16x8 __attribute__((ext_vector_type(8)));
typedef unsigned u32x4 __attribute__((ext_vector_type(4)));
typedef unsigned u32x2 __attribute__((ext_vector_type(2)));

constexpr size_t MiB = 1u << 20;
constexpr size_t WS_WGU = 1 * MiB;
constexpr size_t WS_WD = 45 * MiB;
constexpr size_t WS_WIN0 = 67 * MiB;
constexpr size_t WS_WIN1 = WS_WIN0 + (size_t)RW_IN * D * 2;
constexpr size_t WS_WOUT = WS_WIN1 + (size_t)SB_IN * D * 2;
constexpr size_t WS_WMKV = WS_WOUT + 2 * (size_t)D * D * 2;
constexpr size_t WS_LW = WS_WMKV + (size_t)512 * D * 2;
constexpr size_t WS_MEMB = 83 * MiB;
constexpr size_t WS_MEMKV = 87 * MiB;
constexpr size_t WS_XB = 89 * MiB;
constexpr size_t WS_HP = 121 * MiB;
constexpr size_t WS_HEADS = 209 * MiB;
constexpr size_t WS_END = 241 * MiB;
static_assert(WS_LW + (size_t)768 * 256 * 2 <= WS_MEMB, "ws map");

__device__ __forceinline__ unsigned f2bf(float f) { unsigned u = __builtin_bit_cast(unsigned, f); return (u + 0x7fffu + ((u >> 16) & 1u)) >> 16; }
__device__ __forceinline__ unsigned pk2(float lo, float hi) { return f2bf(lo) | (f2bf(hi) << 16); }
__device__ __forceinline__ float bf2f(unsigned short b) { return __builtin_bit_cast(float, (unsigned)b << 16); }
__device__ __forceinline__ float wave_max(float v) {
#pragma unroll
    for (int o = 1; o < 64; o <<= 1) v = fmaxf(v, __shfl_xor(v, o));
    return v;
}
__device__ __forceinline__ float sigmoidf_(float x) { return 1.f / (1.f + __expf(-x)); }
__device__ __forceinline__ float softplusf_(float x) { return fmaxf(x, 0.f) + log1pf(expf(-fabsf(x))); }
template <int CTRL> __device__ __forceinline__ float dpp_f(float x) { return __builtin_bit_cast(float, __builtin_amdgcn_update_dpp(0, __builtin_bit_cast(int, x), CTRL, 0xf, 0xf, false)); }
__device__ __forceinline__ float rowsum16(float x) { x += dpp_f<0x128>(x); x += dpp_f<0x124>(x); x += dpp_f<0x122>(x); x += dpp_f<0x121>(x); return x; }
__device__ __forceinline__ float wave_sum(float v) {
    v = rowsum16(v);
    const float a0 = __builtin_bit_cast(float, __builtin_amdgcn_readlane(__builtin_bit_cast(int, v), 0)), a1 = __builtin_bit_cast(float, __builtin_amdgcn_readlane(__builtin_bit_cast(int, v), 16));
    const float a2 = __builtin_bit_cast(float, __builtin_amdgcn_readlane(__builtin_bit_cast(int, v), 32)), a3 = __builtin_bit_cast(float, __builtin_amdgcn_readlane(__builtin_bit_cast(int, v), 48));
    return (a0 + a1) + (a2 + a3);
}

namespace pg8 {
struct EpiSwiglu {
    static constexpr bool PERM = true, AFTER_DRAIN = false;
    bf16_t* H; int ldh;
    __device__ __forceinline__ void operator()(const f32x4 (&acc)[2][2][4][2], const Unit& u, int wr, int wc, int fr, int fq) const {
        const int row0 = u.pm * BM + wr * 64 + fr, col0 = u.pn * HALF + wc * 32 + 8 * fq;
#pragma unroll
        for (int ai = 0; ai < 2; ++ai)
#pragma unroll
            for (int m = 0; m < 4; ++m) {
                float hv[8];
#pragma unroll
                for (int n = 0; n < 2; ++n)
#pragma unroll
                    for (int j = 0; j < 4; ++j) { const float g = acc[ai][0][m][n][j], up = acc[ai][1][m][n][j];
                        hv[n * 4 + j] = g * __builtin_amdgcn_rcpf(1.0f + __builtin_amdgcn_exp2f(-1.4426950408889634f * g)) * up; }
                u32x4 w; w.x = cvt_pk_bf16(hv[0], hv[1]); w.y = cvt_pk_bf16(hv[2], hv[3]); w.z = cvt_pk_bf16(hv[4], hv[5]); w.w = cvt_pk_bf16(hv[6], hv[7]);
                *(u32x4*)(H + (size_t)(row0 + ai * HALF + m * 16) * ldh + col0) = w;
            }
    }
};
struct EpiRes {
    static constexpr bool PERM = false, AFTER_DRAIN = false;
    float* X; float ra, s;
    __device__ __forceinline__ void operator()(const f32x4 (&acc)[2][2][4][2], const Unit& u, int wr, int wc, int fr, int fq) const {
        const int row0 = u.pm * BM + wr * 64 + fr, col0 = u.pn * BM + wc * 32 + 4 * fq;
#pragma unroll
        for (int ai = 0; ai < 2; ++ai)
#pragma unroll
            for (int m = 0; m < 4; ++m) { float* rowp = X + (size_t)(row0 + ai * HALF + m * 16) * 1024 + col0;
#pragma unroll
                for (int bj = 0; bj < 2; ++bj)
#pragma unroll
                    for (int n = 0; n < 2; ++n) { f32x4* p = (f32x4*)(rowp + bj * HALF + n * 16); const f32x4 v = *p; *p = v * ra + acc[ai][bj][m][n] * s; } }
    }
};
}

struct TDesc { const float* src; bf16* dst; int K, N, mode, first; };
constexpr int NDESC = 24;
struct Args {
    const float* x; const float* mem; const float* ln_g; const float* ln_b;
    const float *mu, *w0, *a0, *k_k, *k_a, *r_k, *lnx_g, *lnx_b;
    float* out; unsigned char* ws;
    TDesc td[NDESC]; int nitems; int ph_lo, ph_hi, dup;
};

__device__ __forceinline__ void p0_transpose_item(const float* W, int K, int N, bf16* WT, int mode, LAS float* scr, int item, int lane) {
    const int nblk = N / 32, kb = item / nblk, nb = item % nblk, k0 = 64 * kb, n0 = 32 * nb;
#pragma unroll 8
    for (int i = 0; i < 32; ++i) { const int kk = 2 * i + (lane >> 5); scr[kk * 33 + (lane & 31)] = W[(size_t)(k0 + kk) * N + n0 + (lane & 31)]; }
    asm volatile("s_waitcnt lgkmcnt(0)" ::: "memory");
    const int c = lane & 7;
    const int rbase = mode == 0 ? n0 : (256 * (n0 >> 7) + (n0 & 127) + (mode == 2 ? 128 : 0));
#pragma unroll
    for (int j = 0; j < 4; ++j) { const int n = (lane >> 3) + 8 * j; const LAS float* s = scr + (8 * c) * 33 + n;
        u32x4 o; o.x = pk2(s[0 * 33], s[1 * 33]); o.y = pk2(s[2 * 33], s[3 * 33]); o.z = pk2(s[4 * 33], s[5 * 33]); o.w = pk2(s[6 * 33], s[7 * 33]);
        *(u32x4*)(WT + (size_t)(rbase + n) * K + k0 + 8 * c) = o; }
    asm volatile("s_waitcnt lgkmcnt(0)" ::: "memory");
}
__device__ __forceinline__ void p0_prologue(const Args& a, LAS unsigned char* lds, int gw, int ngw, int wave, int lane) {
    LAS float* scr = (LAS float*)(lds + wave * 16384);
    for (int it = gw; it < a.nitems; it += ngw) {
        int d = 0;
#pragma unroll 1
        for (int j = 1; j < NDESC; ++j) if (it >= a.td[j].first) d = j;
        p0_transpose_item(a.td[d].src, a.td[d].K, a.td[d].N, a.td[d].dst, a.td[d].mode, scr, it - a.td[d].first, lane);
    }
    bf16* xb = (bf16*)(a.ws + WS_XB); bf16* memb = (bf16*)(a.ws + WS_MEMB);
    for (int r = gw; r < M + NB * NMEM; r += ngw) {
        const bool isx = r < M; const int rr = isx ? r : r - M;
        const f32x4* s = (const f32x4*)((isx ? a.x : a.mem) + (size_t)rr * D) + lane;
        u32x2* o = (u32x2*)((isx ? xb : memb) + (size_t)rr * D) + lane;
#pragma unroll
        for (int j = 0; j < 4; ++j) { const f32x4 v = s[64 * j]; if (isx) ((f32x4*)(a.out + (size_t)rr * D))[lane + 64 * j] = v;
            u32x2 w; w.x = pk2(v[0], v[1]); w.y = pk2(v[2], v[3]); o[64 * j] = w; }
    }
}

__device__ __forceinline__ void ln_phase(const Args& a, unsigned char* ws, int li, int gw, int ngw, int lane, bool neutral) {
    const float* g = a.ln_g + (size_t)li * D; const float* b = a.ln_b + (size_t)li * D;
    bf16* xb = (bf16*)(ws + WS_XB);
    f32x4 gg[4], bb[4];
#pragma unroll
    for (int j = 0; j < 4; ++j) { gg[j] = ((const f32x4*)g)[lane + 64 * j]; bb[j] = ((const f32x4*)b)[lane + 64 * j]; }
    for (int row = gw; row < M; row += ngw) {
        f32x4* tr = (f32x4*)(a.out + (size_t)row * D) + lane;
        f32x4 v[4]; float s = 0.f;
#pragma unroll
        for (int j = 0; j < 4; ++j) { v[j] = tr[64 * j]; s += (v[j][0] + v[j][1]) + (v[j][2] + v[j][3]); }
        const float mean = wave_sum(s) * (1.f / D); float s2 = 0.f;
#pragma unroll
        for (int j = 0; j < 4; ++j) { v[j] = v[j] - mean; s2 += (v[j][0] * v[j][0] + v[j][1] * v[j][1]) + (v[j][2] * v[j][2] + v[j][3] * v[j][3]); }
        const float rstd = rsqrtf(wave_sum(s2) * (1.f / D) + LN_EPS);
        u32x2* o = (u32x2*)(xb + (size_t)row * D) + lane;
#pragma unroll
        for (int j = 0; j < 4; ++j) { const f32x4 y = neutral ? v[j] + mean : v[j] * rstd * gg[j] + bb[j]; tr[64 * j] = y; u32x2 w; w.x = pk2(y[0], y[1]); w.y = pk2(y[2], y[3]); o[64 * j] = w; }
    }
}

typedef short v4i16_t __attribute__((ext_vector_type(4)));
__device__ __forceinline__ int crow(int r, int hi) { return (r & 3) + 8 * (r >> 2) + 4 * hi; }
__device__ __forceinline__ unsigned cvtpk(float lo, float hi) { typedef float f2 __attribute__((ext_vector_type(2))); typedef __bf16 b2 __attribute__((ext_vector_type(2))); f2 v = {lo, hi}; b2 b = __builtin_convertvector(v, b2); return __builtin_bit_cast(unsigned, b); }
__device__ __forceinline__ void at_load_k(bf16x8 (&kf)[8], const bf16* Kt, int ldk, int r32, int hi) {
#pragma unroll
    for (int kh = 0; kh < 2; ++kh)
#pragma unroll
        for (int d0 = 0; d0 < 4; ++d0) kf[kh * 4 + d0] = *(const bf16x8*)(Kt + (size_t)(32 * kh + r32) * ldk + 16 * d0 + 8 * hi);
}
__device__ __forceinline__ void at_load_v(u32x4 (&vr)[8], const bf16* Vt, int ldk, int lane) {
#pragma unroll
    for (int p = 0; p < 8; ++p) vr[p] = *(const u32x4*)(Vt + (size_t)(16 * (p & 3) + (lane >> 2)) * ldk + 32 * (p >> 2) + 8 * (lane & 3));
}
__device__ __forceinline__ void at_store_v(const u32x4 (&vr)[8], LAS unsigned char* vl, int lane) {
#pragma unroll
    for (int p = 0; p < 8; ++p) *(LAS u32x4*)(vl + p * 1024 + lane * 16) = vr[p];
}
__device__ __forceinline__ void at_qk(f32x16& p0, f32x16& p1, const bf16x8 (&kf)[8], const bf16x8 (&qr)[4]) {
    const f32x16 z = {0.f, 0.f, 0.f, 0.f, 0.f, 0.f, 0.f, 0.f, 0.f, 0.f, 0.f, 0.f, 0.f, 0.f, 0.f, 0.f};
    p0 = z; p1 = z;
#pragma unroll
    for (int d0 = 0; d0 < 4; ++d0) { p0 = __builtin_amdgcn_mfma_f32_32x32x16_bf16(kf[d0], qr[d0], p0, 0, 0, 0); p1 = __builtin_amdgcn_mfma_f32_32x32x16_bf16(kf[4 + d0], qr[d0], p1, 0, 0, 0); }
}
__device__ __forceinline__ void at_pv(f32x16 (&o)[2], const f32x16& a0, const f32x16& a1, const LAS unsigned char* vl, int lane) {
    const int hi = lane >> 5;
    const LAS unsigned char* vp = vl + ((lane >> 4) & 1) * 32 + (lane & 3) * 8 + (4 * hi + ((lane & 15) >> 2)) * 64;
    u32x4 pw[4];
    pw[0] = (u32x4){cvtpk(a0[0], a0[1]), cvtpk(a0[2], a0[3]), cvtpk(a0[4], a0[5]), cvtpk(a0[6], a0[7])};
    pw[1] = (u32x4){cvtpk(a0[8], a0[9]), cvtpk(a0[10], a0[11]), cvtpk(a0[12], a0[13]), cvtpk(a0[14], a0[15])};
    pw[2] = (u32x4){cvtpk(a1[0], a1[1]), cvtpk(a1[2], a1[3]), cvtpk(a1[4], a1[5]), cvtpk(a1[6], a1[7])};
    pw[3] = (u32x4){cvtpk(a1[8], a1[9]), cvtpk(a1[10], a1[11]), cvtpk(a1[12], a1[13]), cvtpk(a1[14], a1[15])};
#pragma unroll
    for (int dh = 0; dh < 2; ++dh)
#pragma unroll
        for (int kg = 0; kg < 4; ++kg) {
            const v4i16_t lo = __builtin_amdgcn_ds_read_tr16_b64_v4i16((LAS v4i16_t*)(vp + dh * 4096 + kg * 1024));
            const v4i16_t hh = __builtin_amdgcn_ds_read_tr16_b64_v4i16((LAS v4i16_t*)(vp + dh * 4096 + kg * 1024 + 512));
            const bf16x8 vf = {lo[0], lo[1], lo[2], lo[3], hh[0], hh[1], hh[2], hh[3]};
            o[dh] = __builtin_amdgcn_mfma_f32_32x32x16_bf16(__builtin_bit_cast(bf16x8, pw[kg]), vf, o[dh], 0, 0, 0);
        }
}
constexpr int AT_VL = 0, AT_WS = 65536;

__device__ __forceinline__ void memattn_phase(unsigned char* ws, LAS unsigned char* lds, int ldp, int mq_off, int gw, int ngw) {
    const bf16* proj = (const bf16*)(ws + WS_HP); const bf16* memkv = (const bf16*)(ws + WS_MEMKV); bf16* heads = (bf16*)(ws + WS_HEADS);
    int tid_l = threadIdx.x; asm volatile("" : "+v"(tid_l)); const int tid = tid_l, lane = tid & 63, wave = __builtin_amdgcn_readfirstlane(tid >> 6), r32 = lane & 31, hi = lane >> 5;
    LAS unsigned char* vl = lds + AT_VL + wave * 8192; LAS float* wsf = (LAS float*)(lds + AT_WS + wave * 256);
    for (int u = gw; u < NB * 4 * (SEQ / 32); u += ngw) {
        const int tg = u % (SEQ / 32), bh = u / (SEQ / 32), hm = bh & 3, b = bh >> 2;
        const bf16* Q = proj + ((size_t)b * SEQ + tg * 32) * ldp + mq_off + hm * 64;
        const bf16* K = memkv + (size_t)b * NMEM * 512 + hm * 64; const bf16* V = K + 256;
        bf16x8 qr[4];
#pragma unroll
        for (int d0 = 0; d0 < 4; ++d0) qr[d0] = *(const bf16x8*)(Q + (size_t)r32 * ldp + 16 * d0 + 8 * hi);
        bf16x8 kf[8]; f32x16 p0, p1;
        float mx = -3.0e38f;
#pragma unroll 1
        for (int t = 0; t < 4; ++t) {
            at_load_k(kf, K + (size_t)t * 64 * 512, 512, r32, hi); at_qk(p0, p1, kf, qr);
#pragma unroll
            for (int r = 0; r < 16; ++r) mx = fmaxf(mx, fmaxf(p0[r], p1[r]));
        }
        { auto rr = __builtin_amdgcn_permlane32_swap(__float_as_uint(mx), __float_as_uint(mx), false, false); mx = fmaxf(__uint_as_float(rr[0]), __uint_as_float(rr[1])); }
        const float c2 = 0.125f * 1.4426950408889634f; const float mc = mx * c2;
        f32x16 o[2]; o[0] = (f32x16){0.f, 0.f, 0.f, 0.f, 0.f, 0.f, 0.f, 0.f, 0.f, 0.f, 0.f, 0.f, 0.f, 0.f, 0.f, 0.f}; o[1] = o[0];
        float lsum = 0.f; u32x4 vr[8];
#pragma unroll 1
        for (int t = 0; t < 4; ++t) {
            at_load_k(kf, K + (size_t)t * 64 * 512, 512, r32, hi); at_load_v(vr, V + (size_t)t * 64 * 512, 512, lane);
            at_qk(p0, p1, kf, qr);
#pragma unroll
            for (int r = 0; r < 16; ++r) { p0[r] = __builtin_amdgcn_exp2f(p0[r] * c2 - mc); p1[r] = __builtin_amdgcn_exp2f(p1[r] * c2 - mc); lsum += p0[r] + p1[r]; }
            at_store_v(vr, vl, lane);
            at_pv(o, p0, p1, vl, lane);
        }
        { auto rr = __builtin_amdgcn_permlane32_swap(__float_as_uint(lsum), __float_as_uint(lsum), false, false); lsum = __uint_as_float(rr[0]) + __uint_as_float(rr[1]); }
        if (hi == 0) wsf[r32] = lsum;
        bf16* Ob = heads + ((size_t)b * SEQ + tg * 32) * D + C + hm * 64;
#pragma unroll
        for (int r = 0; r < 16; ++r) { const int q = crow(r, hi); const float inv = 1.f / wsf[q];
            Ob[(size_t)q * D + r32] = (bf16)f2bf(o[0][r] * inv); Ob[(size_t)q * D + 32 + r32] = (bf16)f2bf(o[1][r] * inv); }
    }
}

__device__ __forceinline__ void sb_phase(unsigned char* ws, LAS unsigned char* lds, int gw, int ngw) {
    const bf16* proj = (const bf16*)(ws + WS_HP); bf16* heads = (bf16*)(ws + WS_HEADS);
    int tid_l = threadIdx.x; asm volatile("" : "+v"(tid_l)); const int tid = tid_l, lane = tid & 63, wave = __builtin_amdgcn_readfirstlane(tid >> 6), r32 = lane & 31, hi = lane >> 5;
    LAS unsigned char* vl = lds + AT_VL + wave * 8192;
    for (int u = gw; u < NB * NH * (SEQ / 32); u += ngw) {
        const int bh = u % (NB * NH), rg = u / (NB * NH), b = bh / NH, h = bh % NH;
        const bf16* pb = proj + (size_t)b * SEQ * SB_IN + h * 64;
        const int R0 = rg * 32, tq = R0 + r32;
        bf16x8 qr[4];
#pragma unroll
        for (int d0 = 0; d0 < 4; ++d0) qr[d0] = *(const bf16x8*)(pb + (size_t)tq * SB_IN + 16 * d0 + 8 * hi);
        f32x16 o[2]; o[0] = (f32x16){0.f, 0.f, 0.f, 0.f, 0.f, 0.f, 0.f, 0.f, 0.f, 0.f, 0.f, 0.f, 0.f, 0.f, 0.f, 0.f}; o[1] = o[0];
        float carry = 1.f;
        bf16x8 kf[8]; u32x4 vr[8]; f32x16 p0, p1, k0, k1;
        int t = (R0 + 30) >> 6; if (R0 == 0) t = 0;
        at_load_k(kf, pb + C + (size_t)t * 64 * SB_IN, SB_IN, r32, hi); at_load_v(vr, pb + 2 * C + (size_t)t * 64 * SB_IN, SB_IN, lane);
#pragma unroll 1
        for (; t >= 0; --t) {
            at_qk(p0, p1, kf, qr);
            at_store_v(vr, vl, lane);
            if (t > 0) { at_load_k(kf, pb + C + (size_t)(t - 1) * 64 * SB_IN, SB_IN, r32, hi); at_load_v(vr, pb + 2 * C + (size_t)(t - 1) * 64 * SB_IN, SB_IN, lane); }
            const bool edge = (t * 64 + 63 >= R0);
#pragma unroll
            for (int r = 0; r < 16; ++r) {
                { const float z = p0[r], e = __builtin_amdgcn_exp2f(-fabsf(z) * (0.125f * 1.4426950408889634f)), rr = __builtin_amdgcn_rcpf(1.f + e), sm = e * rr;
                  float sg = z >= 0.f ? rr : sm, kp = z >= 0.f ? sm : rr;
                  if (edge) { const bool ok = (t * 64 + crow(r, hi)) < tq; sg = ok ? sg : 0.f; kp = ok ? kp : 1.f; }
                  p0[r] = sg; k0[r] = kp; }
                { const float z = p1[r], e = __builtin_amdgcn_exp2f(-fabsf(z) * (0.125f * 1.4426950408889634f)), rr = __builtin_amdgcn_rcpf(1.f + e), sm = e * rr;
                  float sg = z >= 0.f ? rr : sm, kp = z >= 0.f ? sm : rr;
                  if (edge) { const bool ok = (t * 64 + 32 + crow(r, hi)) < tq; sg = ok ? sg : 0.f; kp = ok ? kp : 1.f; }
                  p1[r] = sg; k1[r] = kp; }
            }
            float ge[8], go[8];
#pragma unroll
            for (int i = 0; i < 4; ++i) {
                const float g0 = (k0[4 * i] * k0[4 * i + 1]) * (k0[4 * i + 2] * k0[4 * i + 3]), g1 = (k1[4 * i] * k1[4 * i + 1]) * (k1[4 * i + 2] * k1[4 * i + 3]);
                auto ra = __builtin_amdgcn_permlane32_swap(__float_as_uint(g0), __float_as_uint(g0), false, false); ge[i] = __uint_as_float(ra[0]); go[i] = __uint_as_float(ra[1]);
                auto rb = __builtin_amdgcn_permlane32_swap(__float_as_uint(g1), __float_as_uint(g1), false, false); ge[4 + i] = __uint_as_float(rb[0]); go[4 + i] = __uint_as_float(rb[1]);
            }
            float X = carry, xo[8];
#pragma unroll
            for (int i = 7; i >= 0; --i) { const float xodd = X; X *= go[i]; const float xeven = X; X *= ge[i]; xo[i] = hi ? xodd : xeven; }
            carry = X;
#pragma unroll
            for (int i = 0; i < 4; ++i) {
                { float x = xo[i]; p0[4 * i + 3] *= x; x *= k0[4 * i + 3]; p0[4 * i + 2] *= x; x *= k0[4 * i + 2]; p0[4 * i + 1] *= x; x *= k0[4 * i + 1]; p0[4 * i] *= x; }
                { float x = xo[4 + i]; p1[4 * i + 3] *= x; x *= k1[4 * i + 3]; p1[4 * i + 2] *= x; x *= k1[4 * i + 2]; p1[4 * i + 1] *= x; x *= k1[4 * i + 1]; p1[4 * i] *= x; }
            }
            at_pv(o, p0, p1, vl, lane);
            if (__all(carry < 1e-30f)) break;
        }
        bf16* Ob = heads + ((size_t)b * SEQ + R0) * D + h * 64;
#pragma unroll
        for (int r = 0; r < 16; ++r) { const int q = crow(r, hi); Ob[(size_t)q * D + r32] = (bf16)f2bf(o[0][r]); Ob[(size_t)q * D + 32 + r32] = (bf16)f2bf(o[1][r]); }
    }
}

template <int KS> __device__ __forceinline__ void mma32(f32x16& acc, const LAS bf16* A, int lda, const LAS bf16* B, int ldb, int lane) {
    const int r = lane & 31, hh = lane >> 5;
#pragma unroll
    for (int ks = 0; ks < KS; ++ks) {
        const bf16x8 av = *(const LAS bf16x8*)(A + r * lda + ks * 16 + hh * 8);
        const bf16x8 bv = *(const LAS bf16x8*)(B + r * ldb + ks * 16 + hh * 8);
        acc = __builtin_amdgcn_mfma_f32_32x32x16_bf16(av, bv, acc, 0, 0, 0);
    }
}
constexpr int RK_CH = 32;
constexpr int RL_RZ = 0, RL_KZ = 8192, RL_VZ = 16384, RL_WL = 24576, RL_AL = 32768, RL_GG = 40960, RL_LO = 49152, RL_SV = 66048, RL_SC = 107008, RL_LW = 107520, RL_MU = 143360, RL_END = 145152;
constexpr int LO_LD = 264, LW_LD = 72, LG_LD = 136;
static_assert(RL_END <= LDS_BYTES, "rwkv lds");
__device__ __forceinline__ void rwkv_phase(const Args& a, unsigned char* ws, LAS unsigned char* lds, int unit) {
    int tid_l = threadIdx.x; asm volatile("" : "+v"(tid_l)); const int b = unit / NH, h = unit % NH, tid = tid_l, lane = tid & 63, wave = tid >> 6;
    const bf16* proj = (const bf16*)(ws + WS_HP) + (size_t)b * SEQ * RW_IN; bf16* heads = (bf16*)(ws + WS_HEADS) + (size_t)b * SEQ * D;
    LAS float* RZ = (LAS float*)(lds + RL_RZ); LAS float* KZ = (LAS float*)(lds + RL_KZ); LAS float* VZ = (LAS float*)(lds + RL_VZ);
    LAS float* WL = (LAS float*)(lds + RL_WL); LAS float* AL = (LAS float*)(lds + RL_AL); LAS float* GG = (LAS float*)(lds + RL_GG);
    LAS bf16* LO = (LAS bf16*)(lds + RL_LO); LAS float* SV = (LAS float*)(lds + RL_SV); LAS float* SC = (LAS float*)(lds + RL_SC);
    LAS bf16* LWw = (LAS bf16*)(lds + RL_LW); LAS bf16* LWa = LWw + 64 * LW_LD; LAS bf16* LWg = LWa + 64 * LW_LD;
    LAS float* OUT = KZ;
    { const bf16* gw_ = (const bf16*)(ws + WS_LW) + (size_t)h * 64 * 64; const bf16* ga_ = (const bf16*)(ws + WS_LW) + (size_t)768 * 64 + (size_t)h * 64 * 64;
      const bf16* gg_ = (const bf16*)(ws + WS_LW) + (size_t)768 * 128 + (size_t)h * 64 * 128;
      for (int i = tid; i < 64 * 64; i += NT) { const int n = i >> 6, k = i & 63; LWw[n * LW_LD + k] = gw_[i]; LWa[n * LW_LD + k] = ga_[i]; }
      for (int i = tid; i < 64 * 128; i += NT) { const int n = i >> 7, k = i & 127; LWg[n * LG_LD + k] = gg_[i]; } }
    LAS float* MU = (LAS float*)(lds + RL_MU);
    for (int i = tid; i < 448; i += NT) MU[i] = a.mu[i < 192 ? (i >> 6) * C + h * 64 + (i & 63) : 3 * C + (i - 192)];
    const int cl = lane;
    const int ch = h * 64 + cl;
    const float c_w0 = a.w0[ch], c_a0 = a.a0[ch], c_kk = a.k_k[ch], c_ka = a.k_a[ch], c_rk = a.r_k[ch], c_lg = a.lnx_g[ch], c_lb = a.lnx_b[ch];
    const int jg = lane & 15, r0 = wave * 8 + (lane >> 4) * 2;
    f32x4 S0 = {0.f, 0.f, 0.f, 0.f}, S1 = {0.f, 0.f, 0.f, 0.f};
    LAS bf16* RAW = (LAS bf16*)(lds + RL_SV);
    u32x4 raw[4];
    auto raw_load = [&](int t0) {
#pragma unroll
        for (int j = 0; j < 4; ++j) { const int i = tid + NT * j; const int row = i / 56, seg = i % 56, t = t0 - 1 + row;
            const int col = seg < 24 ? (seg >> 3) * C + h * 64 + (seg & 7) * 8 : 3 * C + (seg - 24) * 8;
            raw[j] = (u32x4){0u, 0u, 0u, 0u};
            if (i < 33 * 56 && t >= 0) raw[j] = *(const u32x4*)(proj + (size_t)t * RW_IN + col); } };
    auto raw_store = [&]() {
#pragma unroll
        for (int j = 0; j < 4; ++j) { const int i = tid + NT * j; if (i < 33 * 56) *(LAS u32x4*)(RAW + i * 8) = raw[j]; } };
    raw_load(0);
    __syncthreads();
    raw_store();
    __syncthreads();
    for (int t0 = 0; t0 < SEQ; t0 += RK_CH) {
#pragma unroll
        for (int j = 0; j < 4; ++j) {
            const int i = tid + NT * j;
            if (i < RK_CH * 56) {
                const int tt = i / 56, sg = i % 56, cc0 = sg * 8;
                const bf16x8 cu = *(const LAS bf16x8*)(RAW + (tt + 1) * 448 + cc0), pv = *(const LAS bf16x8*)(RAW + tt * 448 + cc0);
                const f32x4 m0 = *(const LAS f32x4*)(MU + cc0), m1 = *(const LAS f32x4*)(MU + cc0 + 4);
                float z[8];
#pragma unroll
                for (int e = 0; e < 8; ++e) { const float cur = bf2f((unsigned short)cu[e]), prev = bf2f((unsigned short)pv[e]); z[e] = cur + (prev - cur) * (e < 4 ? m0[e] : m1[e - 4]); }
                if (sg < 24) {
                    LAS float* dst = (sg < 8 ? RZ : (sg < 16 ? KZ : VZ)) + tt * 64 + (cc0 & 63);
                    *(LAS f32x4*)dst = (f32x4){z[0], z[1], z[2], z[3]}; *(LAS f32x4*)(dst + 4) = (f32x4){z[4], z[5], z[6], z[7]};
                } else {
                    const int l0 = cc0 - 192;
#pragma unroll
                    for (int e = 0; e < 8; ++e) {
                        if (l0 < 64) z[e] = 1.f - 2.f * __builtin_amdgcn_rcpf(__builtin_amdgcn_exp2f(z[e] * 2.8853900817779268f) + 1.f);
                        else if (l0 >= 128) z[e] = __builtin_amdgcn_rcpf(1.f + __builtin_amdgcn_exp2f(-1.4426950408889634f * z[e]));
                    }
                    *(LAS u32x4*)(LO + tt * LO_LD + l0) = (u32x4){pk2(z[0], z[1]), pk2(z[2], z[3]), pk2(z[4], z[5]), pk2(z[6], z[7])};
                }
            }
        }
        __syncthreads();
        if (wave < 6) {
            const int mat = wave >> 1, nt = wave & 1;
            f32x16 acc = {0.f, 0.f, 0.f, 0.f, 0.f, 0.f, 0.f, 0.f, 0.f, 0.f, 0.f, 0.f, 0.f, 0.f, 0.f, 0.f};
            if (mat == 0) mma32<4>(acc, LO, LO_LD, LWw + nt * 32 * LW_LD, LW_LD, lane);
            else if (mat == 1) mma32<4>(acc, LO + 64, LO_LD, LWa + nt * 32 * LW_LD, LW_LD, lane);
            else mma32<8>(acc, LO + 128, LO_LD, LWg + nt * 32 * LG_LD, LG_LD, lane);
            LAS float* dst = mat == 0 ? WL : (mat == 1 ? AL : GG);
#pragma unroll
            for (int r = 0; r < 16; ++r) { const int tok = (r & 3) + 8 * (r >> 2) + 4 * (lane >> 5); dst[tok * 64 + nt * 32 + (lane & 31)] = acc[r]; }
        }
        __syncthreads();
#pragma unroll 2
        for (int q = 0; q < 4; ++q) {
            const int tt = wave * 4 + q;
            const float wl = c_w0 + WL[tt * 64 + cl], al = c_a0 + AL[tt * 64 + cl];
            const float wlog = -(fmaxf(-wl, 0.f) + __logf(1.f + __expf(-fabsf(wl)))) - 0.5f, w = __expf(-__expf(wlog)), aa = __builtin_amdgcn_rcpf(1.f + __expf(-al));
            const float r = RZ[tt * 64 + cl], kraw = KZ[tt * 64 + cl];
            const float kkr = kraw * c_kk, ss = wave_sum(kkr * kkr), kkn = kkr * rsqrtf(fmaxf(ss, 1e-24f));
            const float k = kraw * (1.f + (aa - 1.f) * c_ka), bb = kkn * aa;
            const float br = wave_sum(bb * r), kr = wave_sum(k * r), bon = wave_sum(r * k * c_rk);
            LAS float* sv = SV + tt * 320;
            sv[cl] = kkn; sv[64 + cl] = w * r; sv[128 + cl] = w; sv[192 + cl] = bb; sv[256 + cl] = k;
            if (lane == 0) { SC[tt * 4 + 0] = br; SC[tt * 4 + 1] = kr; SC[tt * 4 + 2] = bon; }
        }
        __syncthreads();
        if (t0 + RK_CH < SEQ) raw_load(t0 + RK_CH);
#pragma unroll 2
        for (int tt = 0; tt < RK_CH; ++tt) {
            const LAS float* sv = SV + tt * 320 + 4 * jg;
            const f32x4 k4 = *(const LAS f32x4*)(sv), r4 = *(const LAS f32x4*)(sv + 64), w4 = *(const LAS f32x4*)(sv + 128), b4 = *(const LAS f32x4*)(sv + 192), q4 = *(const LAS f32x4*)(sv + 256);
            const float v0 = VZ[tt * 64 + r0], v1 = VZ[tt * 64 + r0 + 1], br = SC[tt * 4 + 0], kr = SC[tt * 4 + 1];
            float sa0 = (S0[0] * k4[0] + S0[1] * k4[1]) + (S0[2] * k4[2] + S0[3] * k4[3]);
            float p0 = (S0[0] * r4[0] + S0[1] * r4[1]) + (S0[2] * r4[2] + S0[3] * r4[3]);
            float sa1 = (S1[0] * k4[0] + S1[1] * k4[1]) + (S1[2] * k4[2] + S1[3] * k4[3]);
            float p1 = (S1[0] * r4[0] + S1[1] * r4[1]) + (S1[2] * r4[2] + S1[3] * r4[3]);
            sa0 = rowsum16(sa0); p0 = rowsum16(p0); sa1 = rowsum16(sa1); p1 = rowsum16(p1);
            if (jg == 0) { OUT[tt * 64 + r0] = p0 - sa0 * br + v0 * kr; OUT[tt * 64 + r0 + 1] = p1 - sa1 * br + v1 * kr; }
            S0 = S0 * w4 - b4 * sa0 + q4 * v0;
            S1 = S1 * w4 - b4 * sa1 + q4 * v1;
        }
        __syncthreads();
        raw_store();
#pragma unroll 1
        for (int q = 0; q < 4; ++q) {
            const int tt = wave * 4 + q;
            const float o = OUT[tt * 64 + cl];
            const float m = wave_sum(o) * (1.f / 64.f), d = o - m, var = wave_sum(d * d) * (1.f / 64.f);
            const float y = d * rsqrtf(var + LNX_EPS) * c_lg + c_lb;
            const float res = (y + SC[tt * 4 + 2] * VZ[tt * 64 + cl]) * GG[tt * 64 + cl];
            heads[(size_t)(t0 + tt) * D + ch] = (bf16)f2bf(res);
        }
        __syncthreads();
    }
}

#define GAS __attribute__((address_space(1)))
typedef GAS unsigned gu32;
#define XB_TMO      128
#define XB_XCNT(j)  (256  + 64 * (j))
#define XB_XSUB(j)  (1280 + 64 * (j))
#define XB_XGEN(j)  (2304 + 64 * (j))
#define XB_TOP      3328
#define XB_TOPGEN   3392
#define XCD_BAR_WORDS 3456
#define XB_SPIN_CAP (1u << 18)

__device__ __forceinline__ unsigned xb_ld(unsigned* p)              { return __hip_atomic_load(p, __ATOMIC_RELAXED, __HIP_MEMORY_SCOPE_AGENT); }
__device__ __forceinline__ unsigned xb_add(unsigned* p, unsigned v) { return __hip_atomic_fetch_add(p, v, __ATOMIC_RELAXED, __HIP_MEMORY_SCOPE_AGENT); }
__device__ __forceinline__ unsigned xb_xcc_id() { return (unsigned)__builtin_amdgcn_s_getreg((3 << 11) | 20) & 0xFu; }
#define XB_SPIN(cond, bar) do { unsigned _sp = 0; while (cond) { __builtin_amdgcn_s_sleep(1); \
    if ((++_sp & 255u) == 0u) { if (xb_ld(&(bar)[XB_TMO])) break; if (_sp > XB_SPIN_CAP) { atomicAdd(&(bar)[XB_TMO], 1u); break; } } } } while (0)

struct XcdBarrier {
    unsigned* bar; unsigned x;
    volatile LAS unsigned* st;
};

__device__ __forceinline__ XcdBarrier xcd_barrier_post(unsigned* bar, volatile LAS unsigned* st) {
    XcdBarrier b; b.bar = bar; b.x = xb_xcc_id(); b.st = st;
    if (threadIdx.x == 0) (void)xb_add(&bar[XB_XCNT(b.x)], 1u);
    return b;
}
__device__ __forceinline__ void xcd_barrier_complete(unsigned* bar, unsigned x, unsigned& nloc, unsigned& nx) {
    const unsigned G = gridDim.x * gridDim.y * gridDim.z;
    unsigned sum, cnt, mine, sp = 0u;
    for (;;) {
        sum = 0u; cnt = 0u; mine = 0u;
#pragma unroll
        for (unsigned j = 0; j < 16; ++j) { const unsigned c = xb_ld(&bar[XB_XCNT(j)]); sum += c; cnt += (c > 0u) ? 1u : 0u; mine = (j == x) ? c : mine; }
        if (sum == G) break;
        __builtin_amdgcn_s_sleep(1);
        if ((++sp & 255u) == 0u) { if (xb_ld(&bar[XB_TMO])) break; if (sp > XB_SPIN_CAP) { atomicAdd(&bar[XB_TMO], 1u); break; } }
    }
    nloc = mine > 0u ? mine : 1u; nx = cnt > 0u ? cnt : 1u;
}

__device__ __forceinline__ void xcd_barrier(const XcdBarrier& b) {
    asm volatile("s_waitcnt vmcnt(0)" ::: "memory");
    __syncthreads();
    if (threadIdx.x == 0) {
        unsigned* bar = b.bar;
        __builtin_amdgcn_s_waitcnt(0);
        unsigned nloc = b.st[0], nx = b.st[1];
        if (nloc == 0u) { xcd_barrier_complete(bar, b.x, nloc, nx); b.st[0] = nloc; b.st[1] = nx; }
        const unsigned old = xb_add(&bar[XB_XSUB(b.x)], 1u);
        const unsigned gen = old / nloc;
        if (old + 1u == (gen + 1u) * nloc) {
            __builtin_amdgcn_fence(__ATOMIC_RELEASE, "agent");
            asm volatile("s_waitcnt vmcnt(0)" ::: "memory");
            const unsigned og = xb_add(&bar[XB_TOP], 1u);
            const unsigned tg = og / nx;
            if (og + 1u == (tg + 1u) * nx) xb_add(&bar[XB_TOPGEN], 1u);
            else XB_SPIN(xb_ld(&bar[XB_TOPGEN]) == tg, bar);
            __builtin_amdgcn_fence(__ATOMIC_ACQUIRE, "agent");
            xb_add(&bar[XB_XGEN(b.x)], 1u);
            asm volatile("s_waitcnt vmcnt(0)" ::: "memory");
        } else {
            XB_SPIN(xb_ld(&bar[XB_XGEN(b.x)]) == gen, bar);
            __builtin_amdgcn_fence(__ATOMIC_ACQUIRE, "agent");
            asm volatile("s_waitcnt vmcnt(0)" ::: "memory");
        }
    }
    __syncthreads();
}

__global__ void __launch_bounds__(NT, 2) mega(Args a) {
    extern __shared__ __attribute__((aligned(16))) unsigned char lds_raw[];
    LAS unsigned char* lds = (LAS unsigned char*)lds_raw;
    cg::grid_group grid = cg::this_grid();
    const bool coop = (a.ph_hi - a.ph_lo) > 1;
    volatile LAS unsigned* bst = (volatile LAS unsigned*)(lds + LDS_BYTES - 64);
    if (threadIdx.x == 0) { bst[0] = 0u; bst[1] = 0u; }
    __syncthreads();
    XcdBarrier bar; bar.bar = (unsigned*)a.ws; bar.x = 0; bar.st = bst;
    if (coop) bar = xcd_barrier_post((unsigned*)a.ws, bst);
#pragma unroll 1
    for (int ph = a.ph_lo; ph < a.ph_hi; ++ph) {
        int p0_ = __builtin_amdgcn_readfirstlane(ph); asm volatile("" : "+s"(p0_));
        const int nrep = (p0_ == a.dup) ? 2 : 1;
#pragma unroll 1
        for (int rep0 = 0; rep0 < nrep; ++rep0) {
        int p = __builtin_amdgcn_readfirstlane(ph); asm volatile("" : "+s"(p));
        int repv = __builtin_amdgcn_readfirstlane(rep0); asm volatile("" : "+s"(repv)); const bool neutral = repv + 1 < nrep;
        unsigned char* ws = a.ws; asm volatile("" : "+s"(ws));
        int tid_l = threadIdx.x; asm volatile("" : "+v"(tid_l));
        const int tid = tid_l, lane = tid & 63, wave = __builtin_amdgcn_readfirstlane(tid >> 6);
        const int G = gridDim.x, wg = blockIdx.x, gw = wg * NWAVES + wave, ngw = G * NWAVES;
        bf16* xb = (bf16*)(ws + WS_XB); bf16* hp = (bf16*)(ws + WS_HP); bf16* heads = (bf16*)(ws + WS_HEADS);
        if (p == 0) { p0_prologue(a, lds, gw, ngw, wave, lane); __syncthreads(); }
        else {
            const int L = (p - 1) / 10, sub = (p - 1) % 10;
            if (sub == 0 || sub == 7) {
                const int fi = L * 2 + (sub == 7 ? 1 : 0);
                { pg8::Gemm g{xb, (const bf16*)(ws + WS_WGU) + (size_t)fi * 2 * FF * D, M, 2 * FF, D}; pg8::StaticOrder S; S.init(M, 2 * FF, G, wg);
                  pg8::EpiSwiglu E{hp, FF};
                  pg8::gemm_phase<pg8::EpiSwiglu, pg8::StaticOrder, true, true>(lds, g, S, E); }
            } else if (sub == 1 || sub == 8) {
                const int fi = L * 2 + (sub == 8 ? 1 : 0);
                pg8::Gemm g{hp, (const bf16*)(ws + WS_WD) + (size_t)fi * FF * D, M, D, FF}; pg8::StaticOrder S; S.init(M, D, G, wg);
                pg8::EpiRes E{a.out, neutral ? 1.0f : ALPHA, neutral ? 0.0f : 0.5f};
                pg8::gemm_phase<pg8::EpiRes, pg8::StaticOrder, true, true>(lds, g, S, E);
            } else if (sub == 5) {
                pg8::Gemm g{heads, (const bf16*)(ws + WS_WOUT) + (size_t)L * D * D, M, D, D}; pg8::StaticOrder S; S.init(M, D, G, wg);
                pg8::EpiRes E{a.out, neutral ? 1.0f : ALPHA, neutral ? 0.0f : 1.0f};
                pg8::gemm_phase<pg8::EpiRes, pg8::StaticOrder, true, true>(lds, g, S, E);
            } else if (sub == 2 || sub == 6 || sub == 9) {
                ln_phase(a, ws, L * 3 + (sub == 2 ? 0 : (sub == 6 ? 1 : 2)), gw, ngw, lane, neutral);
            } else if (sub == 3) {
                const int nrep = L == 0 ? 2 : 1;
#pragma unroll 1
                for (int rep = 0; rep < nrep; ++rep) {
                    int rp = rep; asm volatile("" : "+s"(rp));
                    const int N = rp == 1 ? 512 : (L == 0 ? RW_IN : SB_IN), Mr = rp == 1 ? NB * NMEM : M;
                    pg8::Gemm g{rp == 1 ? (const bf16*)(ws + WS_MEMB) : xb, (const bf16*)(ws + (rp == 1 ? WS_WMKV : (L == 0 ? WS_WIN0 : WS_WIN1))), Mr, N, D}; pg8::StaticOrder S; S.init(Mr, N, G, wg);
                    pg8::EpiBf16<0> E{rp == 1 ? (bf16*)(ws + WS_MEMKV) : hp, N, nullptr, 0, 0, 1.f};
                    pg8::gemm_phase<pg8::EpiBf16<0>, pg8::StaticOrder, true, true>(lds, g, S, E);
                }
            } else {
                if (L == 0) {
                    if (wg < NB * NH) rwkv_phase(a, ws, lds, wg);
                    else memattn_phase(ws, lds, RW_IN, RW_SHIFT, (wg - NB * NH) * NWAVES + wave, (G - NB * NH) * NWAVES);
                } else {
                    sb_phase(ws, lds, gw, ngw);
                    memattn_phase(ws, lds, SB_IN, 3 * C, gw, ngw);
                }
            }
        }
        }
        if (coop && ph + 1 < a.ph_hi) { if (ph == 0) grid.sync(); else xcd_barrier(bar); }
    }
}
constexpr int NPHASES = 1 + 2 * (3 + 4 + 3);
#ifndef MK_DUP
#define MK_DUP -1
#endif

extern "C" void kernel_launch(void* const* d_in, const int* in_sizes, int n_in, void* d_out, int out_size, void* d_ws, size_t ws_size, hipStream_t stream) {
    static int grid = 0;
    if (grid == 0) {
        if (n_in != 25 || out_size != M * D || ws_size < WS_END) { fprintf(stderr, "kernel_launch: unexpected shapes (n_in %d out %d ws %zu)\n", n_in, out_size, ws_size); grid = -1; return; }
        int dev = 0, cus = 0, per_cu = 0;
        (void)hipGetDevice(&dev); (void)hipDeviceGetAttribute(&cus, hipDeviceAttributeMultiprocessorCount, dev);
        if (hipFuncSetAttribute((const void*)mega, hipFuncAttributeMaxDynamicSharedMemorySize, LDS_BYTES) != hipSuccess) { fprintf(stderr, "kernel_launch: hipFuncSetAttribute failed\n"); grid = -1; return; }
        if (hipOccupancyMaxActiveBlocksPerMultiprocessor(&per_cu, (const void*)mega, NT, LDS_BYTES) != hipSuccess || per_cu < 1) { fprintf(stderr, "kernel_launch: occupancy query failed (%d)\n", per_cu); per_cu = 1; }
        (void)hipGetLastError();
        grid = cus;
        fprintf(stderr, "kernel_launch: cus %d per_cu %d grid %d\n", cus, per_cu, grid);
    }
    if (grid < 0) return;
    Args a{};
    const float* const* in = (const float* const*)d_in;
    a.x = in[0]; a.mem = in[1]; a.ln_g = in[8]; a.ln_b = in[9];
    a.mu = in[13]; a.w0 = in[14]; a.a0 = in[16]; a.k_k = in[19]; a.k_a = in[20]; a.r_k = in[21]; a.lnx_g = in[22]; a.lnx_b = in[23];
    a.out = (float*)d_out; a.ws = (unsigned char*)d_ws;
    unsigned char* ws = (unsigned char*)d_ws;
    int nd = 0, first = 0;
    auto add = [&](const float* src, bf16* dst, int K, int N, int mode) { a.td[nd] = TDesc{src, dst, K, N, mode, first}; first += (K / 64) * (N / 32); ++nd; };
    for (int layer = 0; layer < 2; ++layer)
        for (int f = 0; f < 2; ++f) {
            const int fi = layer * 2 + f; bf16* gu = (bf16*)(ws + WS_WGU) + (size_t)fi * 2 * FF * D;
            add(in[f == 0 ? 2 : 5] + (size_t)layer * D * FF, gu, D, FF, 1);
            add(in[f == 0 ? 3 : 6] + (size_t)layer * D * FF, gu, D, FF, 2);
            add(in[f == 0 ? 4 : 7] + (size_t)layer * FF * D, (bf16*)(ws + WS_WD) + (size_t)fi * FF * D, FF, D, 0);
        }
    add(in[12], (bf16*)(ws + WS_WIN0), D, RW_IN, 0);
    add(in[24], (bf16*)(ws + WS_WIN1), D, SB_IN, 0);
    add(in[10], (bf16*)(ws + WS_WOUT), D, D, 0);
    add(in[10] + (size_t)D * D, (bf16*)(ws + WS_WOUT) + (size_t)D * D, D, D, 0);
    add(in[11], (bf16*)(ws + WS_WMKV), D, 512, 0);
    add(in[15], (bf16*)(ws + WS_LW), 64, C, 0);
    add(in[17], (bf16*)(ws + WS_LW) + (size_t)768 * 64, 64, C, 0);
    add(in[18], (bf16*)(ws + WS_LW) + (size_t)768 * 128, 128, C, 0);
    for (; nd < NDESC; ++nd) a.td[nd] = TDesc{nullptr, nullptr, 64, 32, 0, 0x7fffffff};
    a.nitems = first;
#ifndef MK_SPLIT
    a.ph_lo = 0; a.ph_hi = NPHASES; a.dup = MK_DUP;
    if (hipMemsetAsync(d_ws, 0, 16384, stream) != hipSuccess) { fprintf(stderr, "kernel_launch: memset failed\n"); return; }
    void* args[] = {&a};
    hipError_t e = hipLaunchCooperativeKernel((const void*)mega, dim3(grid), dim3(NT), args, LDS_BYTES, stream);
    if (e != hipSuccess) fprintf(stderr, "cooperative launch failed: %s (grid %d)\n", hipGetErrorString(e), grid);
#else
    a.dup = -1;
    for (int p = 0; p < NPHASES; ++p) { a.ph_lo = p; a.ph_hi = p + 1; hipLaunchKernelGGL(mega, dim3(grid), dim3(NT), LDS_BYTES, stream, a); }
#endif
}
```

```cpp
#include <hip/hip_runtime.h>
#include <hip/hip_cooperative_groups.h>
#include <cstdio>
#include <cstdint>
namespace cg = cooperative_groups;
namespace pg8 {
#define PG8_LAS __attribute__((address_space(3)))
typedef unsigned short bf16_t;
typedef short bf16x8 __attribute__((ext_vector_type(8)));
typedef float f32x4 __attribute__((ext_vector_type(4)));
typedef unsigned u32x4 __attribute__((ext_vector_type(4)));
constexpr int BM = 256, BK = 64, HALF = 128, HTB = HALF * BK * 2  , STAGE_BYTES = 8 * HTB, NXCD = 8, WGM = 8;

__host__ __device__ __forceinline__ int lds_byte(int r, int c) { const int st = (r >> 4) * 2 + (c >> 5), rr = r & 15, cc = c & 31, ob = rr * 64 + cc * 2; return st * 1024 + (ob ^ (((ob >> 9) & 1) << 5)); }
__host__ __device__ __forceinline__ void stage_rc(int b, int& R, int& C) { const int st = b / 1024, sb = b % 1024, swz = sb ^ (((sb >> 9) & 1) << 5); R = (st >> 1) * 16 + swz / 64; C = (st & 1) * 32 + (swz % 64) / 2; }
__host__ __device__ __forceinline__ int perm32(int rho) { const int n = rho >> 4, i = rho & 15; return 8 * (i >> 2) + 4 * n + (i & 3); }

struct Unit { int pm, pn; };
struct Gemm { const bf16_t* A; const bf16_t* Bt; int M, N, K; };

struct StaticOrder {
    int nM, nN, nwg, G, c;
    __host__ __device__ void init(int M, int N, int G_, int c_) { nM = M / BM; nN = N / BM; nwg = nM * nN; G = G_; c = c_; }
    __host__ __device__ bool next(int i, Unit& u) const {
        const long L = (long)i * G + c; if (L >= nwg) return false;
        int wgid = (int)L; { const int q = nwg / NXCD, r = nwg % NXCD, xcd = wgid % NXCD, off = wgid / NXCD; wgid = (xcd < r ? xcd * (q + 1) : r * (q + 1) + (xcd - r) * q) + off; }
        const int nig = WGM * nN, gid = wgid / nig, fm = gid * WGM, gsz = (nM - fm) < WGM ? (nM - fm) : WGM;
        u.pm = fm + ((wgid % nig) % gsz); u.pn = (wgid % nig) / gsz; return true;
    }
    __device__ __forceinline__ void a_ready(const Unit&) const {}
    __device__ __forceinline__ void done(const Unit&) const {}
};

__device__ __forceinline__ unsigned cvt_pk_bf16(float lo, float hi) { unsigned r; asm volatile("v_cvt_pk_bf16_f32 %0, %1, %2" : "=v"(r) : "v"(lo), "v"(hi)); return r; }
typedef float f32x2 __attribute__((ext_vector_type(2)));
__device__ __forceinline__ f32x2 gelu_pk(f32x2 v) {
    const f32x2 av = __builtin_elementwise_abs(v), d = av * 0.2316418882f + 1.0f;
    f32x2 t; t.x = __builtin_amdgcn_rcpf(d.x); t.y = __builtin_amdgcn_rcpf(d.y);
    f32x2 q = t * 0.5307027145f + (-0.7265760135f); q = q * t + 0.7107068705f; q = q * t + (-0.142248368f); q = q * t + 0.127414796f; q = q * t;
    const f32x2 s = (v * v) * (-0.72134752044f);
    f32x2 e; e.x = __builtin_amdgcn_exp2f(s.x); e.y = __builtin_amdgcn_exp2f(s.y);
    const f32x2 m = v * (q * e), r = v - m;
    f32x2 o; o.x = v.x < 0.f ? m.x : r.x; o.y = v.y < 0.f ? m.y : r.y; return o;
}

template <int ACT  > struct EpiBf16 {
    static constexpr bool PERM = true, AFTER_DRAIN = false; static_assert(ACT == 0 || ACT == 1, "EpiBf16: ACT is 0 (none) or 1 (gelu_pk)");
    bf16_t* O; int ldc; const float* bias; int split_cols; size_t split_stride; float scale0;
    __device__ __forceinline__ void operator()(const f32x4 (&acc)[2][2][4][2], const Unit& u, int wr, int wc, int fr, int fq) const {
        const int row0 = u.pm * BM + wr * 64 + fr; int colt = u.pn * BM; bf16_t* base = O;
        float sc = 1.f; if (split_cols) { const int t = colt / split_cols; base += (size_t)t * split_stride; colt -= t * split_cols; if (t == 0) sc = scale0; }
        const int col0 = colt + wc * 32 + 8 * fq, bcol0 = u.pn * BM + wc * 32 + 8 * fq;
        f32x4 bv[2][2];
#pragma unroll
        for (int bj = 0; bj < 2; ++bj)
#pragma unroll
            for (int n = 0; n < 2; ++n) bv[bj][n] = bias ? *(const f32x4*)(bias + bcol0 + bj * HALF + 4 * n) : (f32x4){0.f, 0.f, 0.f, 0.f};
#pragma unroll
        for (int ai = 0; ai < 2; ++ai)
#pragma unroll
            for (int m = 0; m < 4; ++m) { bf16_t* rowp = base + (size_t)(row0 + ai * HALF + m * 16) * ldc + col0;
#pragma unroll
                for (int bj = 0; bj < 2; ++bj) { f32x4 v0 = acc[ai][bj][m][0] + bv[bj][0], v1 = acc[ai][bj][m][1] + bv[bj][1];
                    if (ACT == 1) { f32x2 a = gelu_pk((f32x2){v0[0], v0[1]}), b = gelu_pk((f32x2){v0[2], v0[3]}), c = gelu_pk((f32x2){v1[0], v1[1]}), d = gelu_pk((f32x2){v1[2], v1[3]});
                        v0 = (f32x4){a.x, a.y, b.x, b.y}; v1 = (f32x4){c.x, c.y, d.x, d.y}; }
                    v0 = v0 * sc; v1 = v1 * sc; u32x4 w; w.x = cvt_pk_bf16(v0[0], v0[1]); w.y = cvt_pk_bf16(v0[2], v0[3]); w.z = cvt_pk_bf16(v1[0], v1[1]); w.w = cvt_pk_bf16(v1[2], v1[3]);
                    *(u32x4*)(rowp + bj * HALF) = w; } }
    }
};

template <class Epi, class Sched, bool ALIGN_EPI = false, bool SP2 = false>
__device__ __forceinline__ void gemm_phase(PG8_LAS unsigned char* lds, const Gemm g, const Sched& S, const Epi& E) {
    int tid_l = threadIdx.x; asm volatile("" : "+v"(tid_l));
    const int tid = tid_l, wid = __builtin_amdgcn_readfirstlane(tid >> 6), lane = tid & 63, wr = wid >> 2, wc = wid & 3, fr = lane & 15, fq = lane >> 4;
    const int K = g.K, nt = K / BK;
    unsigned voffA[2], voffB[2];
#pragma unroll
    for (int i = 0; i < 2; ++i) { int R, C; stage_rc(tid * 16 + i * 8192, R, C); const int Rb = Epi::PERM ? ((R & ~31) + perm32(R & 31)) : R;
        voffA[i] = (unsigned)(R * K + C) * 2u; voffB[i] = (unsigned)(Rb * K + C) * 2u; }
    const size_t kstep = (size_t)(BK * 2);
    const size_t hstep = (size_t)HALF * K * 2;
    const size_t tstep = 2 * hstep;
    const unsigned ldsw = (unsigned)wid * 1024u;
    const int aoff = lds_byte(wr * 64 + fr, fq * 8), boff = lds_byte(wc * 32 + fr, fq * 8);
#define PG8_SA(b, h) (((b) * 2 + (h)) * HTB)
#define PG8_SB(b, h) ((4 + (b) * 2 + (h)) * HTB)
#define PG8_STAGE(bufoff, gbase, voff) do { _Pragma("unroll") for (int _i = 0; _i < 2; ++_i) \
        __builtin_amdgcn_global_load_lds((const unsigned*)((const char*)(gbase) + (voff)[_i]), (PG8_LAS unsigned*)(lds + (bufoff) + ldsw + _i * 8192), 16, 0, 0); } while (0)
#define PG8_LDA(dst, b, h) do { _Pragma("unroll") for (int m = 0; m < 4; ++m) _Pragma("unroll") for (int k = 0; k < 2; ++k) dst[m][k] = *(const PG8_LAS bf16x8*)(lds + PG8_SA(b, h) + aoff + m * 2048 + k * 1024); } while (0)
#define PG8_LDB(dst, b, h) do { _Pragma("unroll") for (int n = 0; n < 2; ++n) _Pragma("unroll") for (int k = 0; k < 2; ++k) dst[n][k] = *(const PG8_LAS bf16x8*)(lds + PG8_SB(b, h) + boff + n * 2048 + k * 1024); } while (0)
#define PG8_MMA(ai, bj, At, Bt) do { __builtin_amdgcn_s_setprio(1); _Pragma("unroll") for (int m = 0; m < 4; ++m) _Pragma("unroll") for (int n = 0; n < 2; ++n) _Pragma("unroll") for (int k = 0; k < 2; ++k) \
        acc[ai][bj][m][n] = __builtin_amdgcn_mfma_f32_16x16x32_bf16(Bt[n][k], At[m][k], acc[ai][bj][m][n], 0, 0, 0); __builtin_amdgcn_s_setprio(0); } while (0)
#define PG8_WAIT_V(n) asm volatile("s_waitcnt vmcnt(" #n ")" ::: "memory")
#define PG8_WAIT_L(n) asm volatile("s_waitcnt lgkmcnt(" #n ")" ::: "memory")
#define PG8_BAR __builtin_amdgcn_s_barrier()
#define PG8_SCHED __builtin_amdgcn_sched_barrier(0)
    Unit cur, nxt; int ui = 0;
    if (!S.next(0, cur)) return;
    f32x4 acc[2][2][4][2];
#pragma unroll
    for (int a = 0; a < 2; ++a)
#pragma unroll
        for (int b = 0; b < 2; ++b)
#pragma unroll
            for (int m = 0; m < 4; ++m)
#pragma unroll
                for (int n = 0; n < 2; ++n) acc[a][b][m][n] = (f32x4){0.f, 0.f, 0.f, 0.f};
    bf16x8 At[4][2], B0[2][2], B1[2][2];
    const char* cA = (const char*)g.A + (size_t)cur.pm * tstep; const char* cB = (const char*)g.Bt + (size_t)cur.pn * tstep;
    S.a_ready(cur);
    if constexpr (SP2) {
        PG8_STAGE(PG8_SB(0, 0), cB, voffB); PG8_STAGE(PG8_SB(0, 1), cB + hstep, voffB); PG8_STAGE(PG8_SA(0, 0), cA, voffA); PG8_STAGE(PG8_SA(0, 1), cA + hstep, voffA);
        if (wr == 1) PG8_BAR;
        PG8_WAIT_V(2); PG8_BAR;
        PG8_STAGE(PG8_SB(1, 0), cB + kstep, voffB); PG8_STAGE(PG8_SA(1, 0), cA + kstep, voffA); PG8_STAGE(PG8_SB(1, 1), cB + hstep + kstep, voffB);
        PG8_WAIT_V(6); PG8_BAR;
    } else {
        PG8_STAGE(PG8_SB(0, 0), cB, voffB); PG8_STAGE(PG8_SA(0, 0), cA, voffA); PG8_STAGE(PG8_SB(0, 1), cB + hstep, voffB); PG8_STAGE(PG8_SA(0, 1), cA + hstep, voffA);
        if (wr == 1) PG8_BAR;
        PG8_WAIT_V(4); PG8_BAR;
        PG8_STAGE(PG8_SB(1, 0), cB + kstep, voffB); PG8_STAGE(PG8_SA(1, 0), cA + kstep, voffA); PG8_STAGE(PG8_SB(1, 1), cB + hstep + kstep, voffB);
        PG8_WAIT_V(6); PG8_BAR;
    }
    for (;;) {
        const bool has_next = S.next(ui + 1, nxt);
        const char* nA = has_next ? (const char*)g.A + (size_t)nxt.pm * tstep : cA; const char* nB = has_next ? (const char*)g.Bt + (size_t)nxt.pn * tstep : cB;
        for (int t = 0; t < nt; t += 2) {
            const bool last = (t == nt - 2);
            const char* a1 = cA + (size_t)(t + 1) * kstep;
            const char* a2 = last ? nA : cA + (size_t)(t + 2) * kstep; const char* b2 = last ? nB : cB + (size_t)(t + 2) * kstep;
            const char* a3 = a2 + kstep; const char* b3 = b2 + kstep;
            if (last && has_next) S.a_ready(nxt);
            if constexpr (SP2) {
            PG8_LDB(B0, 0, 0); PG8_LDB(B1, 0, 1); PG8_SCHED; PG8_LDA(At, 0, 0); PG8_STAGE(PG8_SA(1, 1), a1 + hstep, voffA);
            PG8_WAIT_V(8); PG8_WAIT_L(0); PG8_BAR; PG8_MMA(0, 0, At, B0); PG8_MMA(0, 1, At, B1); PG8_BAR; PG8_SCHED;
            PG8_LDA(At, 0, 1); PG8_STAGE(PG8_SB(0, 0), b2, voffB); PG8_STAGE(PG8_SB(0, 1), b2 + hstep, voffB); PG8_STAGE(PG8_SA(0, 0), a2, voffA);
            PG8_WAIT_V(8); PG8_WAIT_L(0); PG8_BAR; PG8_MMA(1, 0, At, B0); PG8_MMA(1, 1, At, B1); PG8_BAR; PG8_SCHED;
            PG8_LDB(B0, 1, 0); PG8_LDB(B1, 1, 1); PG8_SCHED; PG8_LDA(At, 1, 0); PG8_STAGE(PG8_SA(0, 1), a2 + hstep, voffA);
            PG8_WAIT_V(8); PG8_WAIT_L(0); PG8_BAR; PG8_MMA(0, 0, At, B0); PG8_MMA(0, 1, At, B1); PG8_BAR; PG8_SCHED;
            PG8_LDA(At, 1, 1); PG8_STAGE(PG8_SB(1, 0), b3, voffB); PG8_STAGE(PG8_SB(1, 1), b3 + hstep, voffB); PG8_STAGE(PG8_SA(1, 0), a3, voffA);
            PG8_WAIT_V(8); PG8_WAIT_L(0); PG8_BAR; PG8_MMA(1, 0, At, B0); PG8_MMA(1, 1, At, B1); PG8_BAR; PG8_SCHED;
            } else {
            PG8_LDB(B0, 0, 0); PG8_SCHED; PG8_LDA(At, 0, 0); PG8_STAGE(PG8_SA(1, 1), a1 + hstep, voffA);
            PG8_WAIT_L(8); PG8_BAR; PG8_WAIT_L(0); PG8_MMA(0, 0, At, B0); PG8_BAR; PG8_SCHED;
            PG8_LDB(B1, 0, 1); PG8_STAGE(PG8_SB(0, 0), b2, voffB);
            PG8_BAR; PG8_WAIT_L(0); PG8_MMA(0, 1, At, B1); PG8_BAR;
            PG8_LDA(At, 0, 1); PG8_STAGE(PG8_SA(0, 0), a2, voffA);
            PG8_BAR; PG8_WAIT_L(0); PG8_MMA(1, 0, At, B0); PG8_BAR; PG8_SCHED;
            PG8_STAGE(PG8_SB(0, 1), b2 + hstep, voffB);
            PG8_WAIT_V(6); PG8_BAR; PG8_MMA(1, 1, At, B1); PG8_BAR;
            PG8_LDB(B0, 1, 0); PG8_SCHED; PG8_LDA(At, 1, 0); PG8_STAGE(PG8_SA(0, 1), a2 + hstep, voffA);
            PG8_WAIT_L(8); PG8_BAR; PG8_WAIT_L(0); PG8_MMA(0, 0, At, B0); PG8_BAR; PG8_SCHED;
            PG8_LDB(B1, 1, 1); PG8_STAGE(PG8_SB(1, 0), b3, voffB);
            PG8_BAR; PG8_WAIT_L(0); PG8_MMA(0, 1, At, B1); PG8_BAR;
            PG8_LDA(At, 1, 1); PG8_STAGE(PG8_SA(1, 0), a3, voffA);
            PG8_BAR; PG8_WAIT_L(0); PG8_MMA(1, 0, At, B0); PG8_BAR; PG8_SCHED;
            PG8_STAGE(PG8_SB(1, 1), b3 + hstep, voffB);
            PG8_WAIT_V(6); PG8_BAR; PG8_MMA(1, 1, At, B1); PG8_BAR;
            }
        }
        if constexpr (ALIGN_EPI) { if (wr == 0) PG8_BAR; }
        if constexpr (!Epi::AFTER_DRAIN) { E(acc, cur, wr, wc, fr, fq); S.done(cur); }
        if (!has_next) break;
#pragma unroll
        for (int a = 0; a < 2; ++a)
#pragma unroll
            for (int b = 0; b < 2; ++b)
#pragma unroll
                for (int m = 0; m < 4; ++m)
#pragma unroll
                    for (int n = 0; n < 2; ++n) acc[a][b][m][n] = (f32x4){0.f, 0.f, 0.f, 0.f};
        cur = nxt; cA = nA; cB = nB; ++ui;
        if constexpr (ALIGN_EPI) { if (wr == 1) PG8_BAR; }
    }
    PG8_WAIT_V(0);
    if constexpr (!ALIGN_EPI) { if (wr == 0) PG8_BAR; }
    PG8_BAR;
    if constexpr (Epi::AFTER_DRAIN) { E.fused(acc, cur, wr, wc, fr, fq, lds, wid, lane); S.done(cur); }
#undef PG8_SA
#undef PG8_SB
#undef PG8_STAGE
#undef PG8_LDA
#undef PG8_LDB
#undef PG8_MMA
#undef PG8_WAIT_V
#undef PG8_WAIT_L
#undef PG8_BAR
#undef PG8_SCHED
}
}

constexpr int D = 1024, NB = 8, SEQ = 2048, M = NB * SEQ, NMEM = 256;
constexpr int C = 768, NH = 12, FF = 2816;
constexpr int RW_SHIFT = 2560, RW_IN = 2816, SB_IN = 2560;
constexpr float ALPHA = 1.41421356237309515f;
constexpr float LN_EPS = 1e-5f, LNX_EPS = 64e-5f;
constexpr int NWAVES = 8, NT = 512;
constexpr int LDS_BYTES = 159744;

#define LAS __attribute__((address_space(3)))
typedef unsigned short bf16;
typedef float f32x4 __attribute__((ext_vector_type(4)));
typedef float f32x16 __attribute__((ext_vector_type(16)));
typedef short bf16x8 __attribute__((ext_vector_type(8)));
typedef unsigned u32x4 __attribute__((ext_vector_type(4)));
typedef unsigned u32x2 __attribute__((ext_vector_type(2)));

constexpr size_t MiB = 1u << 20;
constexpr size_t WS_WGU = 1 * MiB;
constexpr size_t WS_WD = 45 * MiB;
constexpr size_t WS_WIN0 = 67 * MiB;
constexpr size_t WS_WIN1 = WS_WIN0 + (size_t)RW_IN * D * 2;
constexpr size_t WS_WOUT = WS_WIN1 + (size_t)SB_IN * D * 2;
constexpr size_t WS_WMKV = WS_WOUT + 2 * (size_t)D * D * 2;
constexpr size_t WS_LW = WS_WMKV + (size_t)512 * D * 2;
constexpr size_t WS_MEMB = 83 * MiB;
constexpr size_t WS_MEMKV = 87 * MiB;
constexpr size_t WS_XB = 89 * MiB;
constexpr size_t WS_HP = 121 * MiB;
constexpr size_t WS_HEADS = 209 * MiB;
constexpr size_t WS_END = 241 * MiB;
static_assert(WS_LW + (size_t)768 * 256 * 2 <= WS_MEMB, "ws map");

__device__ __forceinline__ unsigned f2bf(float f) { unsigned u = __builtin_bit_cast(unsigned, f); return (u + 0x7fffu + ((u >> 16) & 1u)) >> 16; }
__device__ __forceinline__ unsigned pk2(float lo, float hi) { return f2bf(lo) | (f2bf(hi) << 16); }
__device__ __forceinline__ float bf2f(unsigned short b) { return __builtin_bit_cast(float, (unsigned)b << 16); }
__device__ __forceinline__ float wave_max(float v) {
#pragma unroll
    for (int o = 1; o < 64; o <<= 1) v = fmaxf(v, __shfl_xor(v, o));
    return v;
}
__device__ __forceinline__ float sigmoidf_(float x) { return 1.f / (1.f + __expf(-x)); }
__device__ __forceinline__ float softplusf_(float x) { return fmaxf(x, 0.f) + log1pf(expf(-fabsf(x))); }
template <int CTRL> __device__ __forceinline__ float dpp_f(float x) { return __builtin_bit_cast(float, __builtin_amdgcn_update_dpp(0, __builtin_bit_cast(int, x), CTRL, 0xf, 0xf, false)); }
__device__ __forceinline__ float rowsum16(float x) { x += dpp_f<0x128>(x); x += dpp_f<0x124>(x); x += dpp_f<0x122>(x); x += dpp_f<0x121>(x); return x; }
__device__ __forceinline__ float wave_sum(float v) {
    v = rowsum16(v);
    const float a0 = __builtin_bit_cast(float, __builtin_amdgcn_readlane(__builtin_bit_cast(int, v), 0)), a1 = __builtin_bit_cast(float, __builtin_amdgcn_readlane(__builtin_bit_cast(int, v), 16));
    const float a2 = __builtin_bit_cast(float, __builtin_amdgcn_readlane(__builtin_bit_cast(int, v), 32)), a3 = __builtin_bit_cast(float, __builtin_amdgcn_readlane(__builtin_bit_cast(int, v), 48));
    return (a0 + a1) + (a2 + a3);
}

namespace pg8 {
struct EpiSwiglu {
    static constexpr bool PERM = true, AFTER_DRAIN = false;
    bf16_t* H; int ldh;
    __device__ __forceinline__ void operator()(const f32x4 (&acc)[2][2][4][2], const Unit& u, int wr, int wc, int fr, int fq) const {
        const int row0 = u.pm * BM + wr * 64 + fr, col0 = u.pn * HALF + wc * 32 + 8 * fq;
#pragma unroll
        for (int ai = 0; ai < 2; ++ai)
#pragma unroll
            for (int m = 0; m < 4; ++m) {
                float hv[8];
#pragma unroll
                for (int n = 0; n < 2; ++n)
#pragma unroll
                    for (int j = 0; j < 4; ++j) { const float g = acc[ai][0][m][n][j], up = acc[ai][1][m][n][j];
                        hv[n * 4 + j] = g * __builtin_amdgcn_rcpf(1.0f + __builtin_amdgcn_exp2f(-1.4426950408889634f * g)) * up; }
                u32x4 w; w.x = cvt_pk_bf16(hv[0], hv[1]); w.y = cvt_pk_bf16(hv[2], hv[3]); w.z = cvt_pk_bf16(hv[4], hv[5]); w.w = cvt_pk_bf16(hv[6], hv[7]);
                *(u32x4*)(H + (size_t)(row0 + ai * HALF + m * 16) * ldh + col0) = w;
            }
    }
};
struct EpiRes {
    static constexpr bool PERM = false, AFTER_DRAIN = false;
    float* X; float ra, s;
    __device__ __forceinline__ void operator()(const f32x4 (&acc)[2][2][4][2], const Unit& u, int wr, int wc, int fr, int fq) const {
        const int row0 = u.pm * BM + wr * 64 + fr, col0 = u.pn * BM + wc * 32 + 4 * fq;
#pragma unroll
        for (int ai = 0; ai < 2; ++ai)
#pragma unroll
            for (int m = 0; m < 4; ++m) { float* rowp = X + (size_t)(row0 + ai * HALF + m * 16) * 1024 + col0;
#pragma unroll
                for (int bj = 0; bj < 2; ++bj)
#pragma unroll
                    for (int n = 0; n < 2; ++n) { f32x4* p = (f32x4*)(rowp + bj * HALF + n * 16); const f32x4 v = *p; *p = v * ra + acc[ai][bj][m][n] * s; } }
    }
};
}

struct TDesc { const float* src; bf16* dst; int K, N, mode, first; };
constexpr int NDESC = 24;
struct Args {
    const float* x; const float* mem; const float* ln_g; const float* ln_b;
    const float *mu, *w0, *a0, *k_k, *k_a, *r_k, *lnx_g, *lnx_b;
    float* out; unsigned char* ws; unsigned* barw;
    TDesc td[NDESC]; int nitems; int pad0;
};

__device__ __forceinline__ void p0_transpose_item(const float* W, int K, int N, bf16* WT, int mode, LAS float* scr, int item, int lane) {
    const int nblk = N / 32, kb = item / nblk, nb = item % nblk, k0 = 64 * kb, n0 = 32 * nb;
#pragma unroll 8
    for (int i = 0; i < 32; ++i) { const int kk = 2 * i + (lane >> 5); scr[kk * 33 + (lane & 31)] = W[(size_t)(k0 + kk) * N + n0 + (lane & 31)]; }
    asm volatile("s_waitcnt lgkmcnt(0)" ::: "memory");
    const int c = lane & 7;
    const int rbase = mode == 0 ? n0 : (256 * (n0 >> 7) + (n0 & 127) + (mode == 2 ? 128 : 0));
#pragma unroll
    for (int j = 0; j < 4; ++j) { const int n = (lane >> 3) + 8 * j; const LAS float* s = scr + (8 * c) * 33 + n;
        u32x4 o; o.x = pk2(s[0 * 33], s[1 * 33]); o.y = pk2(s[2 * 33], s[3 * 33]); o.z = pk2(s[4 * 33], s[5 * 33]); o.w = pk2(s[6 * 33], s[7 * 33]);
        *(u32x4*)(WT + (size_t)(rbase + n) * K + k0 + 8 * c) = o; }
    asm volatile("s_waitcnt lgkmcnt(0)" ::: "memory");
}
__device__ __forceinline__ void p0_prologue(const Args& a, LAS unsigned char* lds, int gw, int ngw, int wave, int lane) {
    LAS float* scr = (LAS float*)(lds + wave * 16384);
    for (int it = gw; it < a.nitems; it += ngw) {
        int d = 0;
#pragma unroll 1
        for (int j = 1; j < NDESC; ++j) if (it >= a.td[j].first) d = j;
        p0_transpose_item(a.td[d].src, a.td[d].K, a.td[d].N, a.td[d].dst, a.td[d].mode, scr, it - a.td[d].first, lane);
    }
    bf16* xb = (bf16*)(a.ws + WS_XB); bf16* memb = (bf16*)(a.ws + WS_MEMB);
    for (int r = gw; r < M + NB * NMEM; r += ngw) {
        const bool isx = r < M; const int rr = isx ? r : r - M;
        const f32x4* s = (const f32x4*)((isx ? a.x : a.mem) + (size_t)rr * D) + lane;
        u32x2* o = (u32x2*)((isx ? xb : memb) + (size_t)rr * D) + lane;
#pragma unroll
        for (int j = 0; j < 4; ++j) { const f32x4 v = s[64 * j]; if (isx) ((f32x4*)(a.out + (size_t)rr * D))[lane + 64 * j] = v;
            u32x2 w; w.x = pk2(v[0], v[1]); w.y = pk2(v[2], v[3]); o[64 * j] = w; }
    }
}

__device__ __forceinline__ void ln_phase(const Args& a, unsigned char* ws, int li, int gw, int ngw, int lane, bool neutral) {
    const float* g = a.ln_g + (size_t)li * D; const float* b = a.ln_b + (size_t)li * D;
    bf16* xb = (bf16*)(ws + WS_XB);
    f32x4 gg[4], bb[4];
#pragma unroll
    for (int j = 0; j < 4; ++j) { gg[j] = ((const f32x4*)g)[lane + 64 * j]; bb[j] = ((const f32x4*)b)[lane + 64 * j]; }
    for (int row = gw; row < M; row += ngw) {
        f32x4* tr = (f32x4*)(a.out + (size_t)row * D) + lane;
        f32x4 v[4]; float s = 0.f;
#pragma unroll
        for (int j = 0; j < 4; ++j) { v[j] = tr[64 * j]; s += (v[j][0] + v[j][1]) + (v[j][2] + v[j][3]); }
        const float mean = wave_sum(s) * (1.f / D); float s2 = 0.f;
#pragma unroll
        for (int j = 0; j < 4; ++j) { v[j] = v[j] - mean; s2 += (v[j][0] * v[j][0] + v[j][1] * v[j][1]) + (v[j][2] * v[j][2] + v[j][3] * v[j][3]); }
        const float rstd = rsqrtf(wave_sum(s2) * (1.f / D) + LN_EPS);
        u32x2* o = (u32x2*)(xb + (size_t)row * D) + lane;
#pragma unroll
        for (int j = 0; j < 4; ++j) { const f32x4 y = neutral ? v[j] + mean : v[j] * rstd * gg[j] + bb[j]; tr[64 * j] = y; u32x2 w; w.x = pk2(y[0], y[1]); w.y = pk2(y[2], y[3]); o[64 * j] = w; }
    }
}

typedef short v4i16_t __attribute__((ext_vector_type(4)));
__device__ __forceinline__ int crow(int r, int hi) { return (r & 3) + 8 * (r >> 2) + 4 * hi; }
__device__ __forceinline__ unsigned cvtpk(float lo, float hi) { typedef float f2 __attribute__((ext_vector_type(2))); typedef __bf16 b2 __attribute__((ext_vector_type(2))); f2 v = {lo, hi}; b2 b = __builtin_convertvector(v, b2); return __builtin_bit_cast(unsigned, b); }
__device__ __forceinline__ void at_load_k(bf16x8 (&kf)[8], const bf16* Kt, int ldk, int r32, int hi) {
#pragma unroll
    for (int kh = 0; kh < 2; ++kh)
#pragma unroll
        for (int d0 = 0; d0 < 4; ++d0) kf[kh * 4 + d0] = *(const bf16x8*)(Kt + (size_t)(32 * kh + r32) * ldk + 16 * d0 + 8 * hi);
}
__device__ __forceinline__ void at_load_v(u32x4 (&vr)[8], const bf16* Vt, int ldk, int lane) {
#pragma unroll
    for (int p = 0; p < 8; ++p) vr[p] = *(const u32x4*)(Vt + (size_t)(16 * (p & 3) + (lane >> 2)) * ldk + 32 * (p >> 2) + 8 * (lane & 3));
}
__device__ __forceinline__ void at_store_v(const u32x4 (&vr)[8], LAS unsigned char* vl, int lane) {
#pragma unroll
    for (int p = 0; p < 8; ++p) *(LAS u32x4*)(vl + p * 1024 + lane * 16) = vr[p];
}
__device__ __forceinline__ void at_qk(f32x16& p0, f32x16& p1, const bf16x8 (&kf)[8], const bf16x8 (&qr)[4]) {
    const f32x16 z = {0.f, 0.f, 0.f, 0.f, 0.f, 0.f, 0.f, 0.f, 0.f, 0.f, 0.f, 0.f, 0.f, 0.f, 0.f, 0.f};
    p0 = z; p1 = z;
#pragma unroll
    for (int d0 = 0; d0 < 4; ++d0) { p0 = __builtin_amdgcn_mfma_f32_32x32x16_bf16(kf[d0], qr[d0], p0, 0, 0, 0); p1 = __builtin_amdgcn_mfma_f32_32x32x16_bf16(kf[4 + d0], qr[d0], p1, 0, 0, 0); }
}
__device__ __forceinline__ void at_pv(f32x16 (&o)[2], const f32x16& a0, const f32x16& a1, const LAS unsigned char* vl, int lane) {
    const int hi = lane >> 5;
    const LAS unsigned char* vp = vl + ((lane >> 4) & 1) * 32 + (lane & 3) * 8 + (4 * hi + ((lane & 15) >> 2)) * 64;
    u32x4 pw[4];
    pw[0] = (u32x4){cvtpk(a0[0], a0[1]), cvtpk(a0[2], a0[3]), cvtpk(a0[4], a0[5]), cvtpk(a0[6], a0[7])};
    pw[1] = (u32x4){cvtpk(a0[8], a0[9]), cvtpk(a0[10], a0[11]), cvtpk(a0[12], a0[13]), cvtpk(a0[14], a0[15])};
    pw[2] = (u32x4){cvtpk(a1[0], a1[1]), cvtpk(a1[2], a1[3]), cvtpk(a1[4], a1[5]), cvtpk(a1[6], a1[7])};
    pw[3] = (u32x4){cvtpk(a1[8], a1[9]), cvtpk(a1[10], a1[11]), cvtpk(a1[12], a1[13]), cvtpk(a1[14], a1[15])};
#pragma unroll
    for (int dh = 0; dh < 2; ++dh)
#pragma unroll
        for (int kg = 0; kg < 4; ++kg) {
            const v4i16_t lo = __builtin_amdgcn_ds_read_tr16_b64_v4i16((LAS v4i16_t*)(vp + dh * 4096 + kg * 1024));
            const v4i16_t hh = __builtin_amdgcn_ds_read_tr16_b64_v4i16((LAS v4i16_t*)(vp + dh * 4096 + kg * 1024 + 512));
            const bf16x8 vf = {lo[0], lo[1], lo[2], lo[3], hh[0], hh[1], hh[2], hh[3]};
            o[dh] = __builtin_amdgcn_mfma_f32_32x32x16_bf16(__builtin_bit_cast(bf16x8, pw[kg]), vf, o[dh], 0, 0, 0);
        }
}
constexpr int AT_VL = 0, AT_WS = 65536;

__device__ __forceinline__ void memattn_phase(unsigned char* ws, LAS unsigned char* lds, int ldp, int mq_off, int gw, int ngw) {
    const bf16* proj = (const bf16*)(ws + WS_HP); const bf16* memkv = (const bf16*)(ws + WS_MEMKV); bf16* heads = (bf16*)(ws + WS_HEADS);
    int tid_l = threadIdx.x; asm volatile("" : "+v"(tid_l)); const int tid = tid_l, lane = tid & 63, wave = __builtin_amdgcn_readfirstlane(tid >> 6), r32 = lane & 31, hi = lane >> 5;
    LAS unsigned char* vl = lds + AT_VL + wave * 8192; LAS float* wsf = (LAS float*)(lds + AT_WS + wave * 256);
    for (int u = gw; u < NB * 4 * (SEQ / 32); u += ngw) {
        const int tg = u % (SEQ / 32), bh = u / (SEQ / 32), hm = bh & 3, b = bh >> 2;
        const bf16* Q = proj + ((size_t)b * SEQ + tg * 32) * ldp + mq_off + hm * 64;
        const bf16* K = memkv + (size_t)b * NMEM * 512 + hm * 64; const bf16* V = K + 256;
        bf16x8 qr[4];
#pragma unroll
        for (int d0 = 0; d0 < 4; ++d0) qr[d0] = *(const bf16x8*)(Q + (size_t)r32 * ldp + 16 * d0 + 8 * hi);
        bf16x8 kf[8]; f32x16 p0, p1;
        float mx = -3.0e38f;
#pragma unroll 1
        for (int t = 0; t < 4; ++t) {
            at_load_k(kf, K + (size_t)t * 64 * 512, 512, r32, hi); at_qk(p0, p1, kf, qr);
#pragma unroll
            for (int r = 0; r < 16; ++r) mx = fmaxf(mx, fmaxf(p0[r], p1[r]));
        }
        { auto rr = __builtin_amdgcn_permlane32_swap(__float_as_uint(mx), __float_as_uint(mx), false, false); mx = fmaxf(__uint_as_float(rr[0]), __uint_as_float(rr[1])); }
        const float c2 = 0.125f * 1.4426950408889634f; const float mc = mx * c2;
        f32x16 o[2]; o[0] = (f32x16){0.f, 0.f, 0.f, 0.f, 0.f, 0.f, 0.f, 0.f, 0.f, 0.f, 0.f, 0.f, 0.f, 0.f, 0.f, 0.f}; o[1] = o[0];
        float lsum = 0.f; u32x4 vr[8];
#pragma unroll 1
        for (int t = 0; t < 4; ++t) {
            at_load_k(kf, K + (size_t)t * 64 * 512, 512, r32, hi); at_load_v(vr, V + (size_t)t * 64 * 512, 512, lane);
            at_qk(p0, p1, kf, qr);
#pragma unroll
            for (int r = 0; r < 16; ++r) { p0[r] = __builtin_amdgcn_exp2f(p0[r] * c2 - mc); p1[r] = __builtin_amdgcn_exp2f(p1[r] * c2 - mc); lsum += p0[r] + p1[r]; }
            at_store_v(vr, vl, lane);
            at_pv(o, p0, p1, vl, lane);
        }
        { auto rr = __builtin_amdgcn_permlane32_swap(__float_as_uint(lsum), __float_as_uint(lsum), false, false); lsum = __uint_as_float(rr[0]) + __uint_as_float(rr[1]); }
        if (hi == 0) wsf[r32] = lsum;
        bf16* Ob = heads + ((size_t)b * SEQ + tg * 32) * D + C + hm * 64;
#pragma unroll
        for (int r = 0; r < 16; ++r) { const int q = crow(r, hi); const float inv = 1.f / wsf[q];
            Ob[(size_t)q * D + r32] = (bf16)f2bf(o[0][r] * inv); Ob[(size_t)q * D + 32 + r32] = (bf16)f2bf(o[1][r] * inv); }
    }
}

__device__ __forceinline__ void sb_phase(unsigned char* ws, LAS unsigned char* lds, int gw, int ngw) {
    const bf16* proj = (const bf16*)(ws + WS_HP); bf16* heads = (bf16*)(ws + WS_HEADS);
    int tid_l = threadIdx.x; asm volatile("" : "+v"(tid_l)); const int tid = tid_l, lane = tid & 63, wave = __builtin_amdgcn_readfirstlane(tid >> 6), r32 = lane & 31, hi = lane >> 5;
    LAS unsigned char* vl = lds + AT_VL + wave * 8192;
    for (int u = gw; u < NB * NH * (SEQ / 32); u += ngw) {
        const int bh = u % (NB * NH), rg = u / (NB * NH), b = bh / NH, h = bh % NH;
        const bf16* pb = proj + (size_t)b * SEQ * SB_IN + h * 64;
        const int R0 = rg * 32, tq = R0 + r32;
        bf16x8 qr[4];
#pragma unroll
        for (int d0 = 0; d0 < 4; ++d0) qr[d0] = *(const bf16x8*)(pb + (size_t)tq * SB_IN + 16 * d0 + 8 * hi);
        f32x16 o[2]; o[0] = (f32x16){0.f, 0.f, 0.f, 0.f, 0.f, 0.f, 0.f, 0.f, 0.f, 0.f, 0.f, 0.f, 0.f, 0.f, 0.f, 0.f}; o[1] = o[0];
        float carry = 1.f;
        bf16x8 kf[8]; u32x4 vr[8]; f32x16 p0, p1, k0, k1;
        int t = (R0 + 30) >> 6; if (R0 == 0) t = 0;
        at_load_k(kf, pb + C + (size_t)t * 64 * SB_IN, SB_IN, r32, hi); at_load_v(vr, pb + 2 * C + (size_t)t * 64 * SB_IN, SB_IN, lane);
#pragma unroll 1
        for (; t >= 0; --t) {
            at_qk(p0, p1, kf, qr);
            at_store_v(vr, vl, lane);
            if (t > 0) { at_load_k(kf, pb + C + (size_t)(t - 1) * 64 * SB_IN, SB_IN, r32, hi); at_load_v(vr, pb + 2 * C + (size_t)(t - 1) * 64 * SB_IN, SB_IN, lane); }
            const bool edge = (t * 64 + 63 >= R0);
#pragma unroll
            for (int r = 0; r < 16; ++r) {
                { const float z = p0[r], e = __builtin_amdgcn_exp2f(-fabsf(z) * (0.125f * 1.4426950408889634f)), rr = __builtin_amdgcn_rcpf(1.f + e), sm = e * rr;
                  float sg = z >= 0.f ? rr : sm, kp = z >= 0.f ? sm : rr;
                  if (edge) { const bool ok = (t * 64 + crow(r, hi)) < tq; sg = ok ? sg : 0.f; kp = ok ? kp : 1.f; }
                  p0[r] = sg; k0[r] = kp; }
                { const float z = p1[r], e = __builtin_amdgcn_exp2f(-fabsf(z) * (0.125f * 1.4426950408889634f)), rr = __builtin_amdgcn_rcpf(1.f + e), sm = e * rr;
                  float sg = z >= 0.f ? rr : sm, kp = z >= 0.f ? sm : rr;
                  if (edge) { const bool ok = (t * 64 + 32 + crow(r, hi)) < tq; sg = ok ? sg : 0.f; kp = ok ? kp : 1.f; }
                  p1[r] = sg; k1[r] = kp; }
            }
            float ge[8], go[8];
#pragma unroll
            for (int i = 0; i < 4; ++i) {
                const float g0 = (k0[4 * i] * k0[4 * i + 1]) * (k0[4 * i + 2] * k0[4 * i + 3]), g1 = (k1[4 * i] * k1[4 * i + 1]) * (k1[4 * i + 2] * k1[4 * i + 3]);
                auto ra = __builtin_amdgcn_permlane32_swap(__float_as_uint(g0), __float_as_uint(g0), false, false); ge[i] = __uint_as_float(ra[0]); go[i] = __uint_as_float(ra[1]);
                auto rb = __builtin_amdgcn_permlane32_swap(__float_as_uint(g1), __float_as_uint(g1), false, false); ge[4 + i] = __uint_as_float(rb[0]); go[4 + i] = __uint_as_float(rb[1]);
            }
            float X = carry, xo[8];
#pragma unroll
            for (int i = 7; i >= 0; --i) { const float xodd = X; X *= go[i]; const float xeven = X; X *= ge[i]; xo[i] = hi ? xodd : xeven; }
            carry = X;
#pragma unroll
            for (int i = 0; i < 4; ++i) {
                { float x = xo[i]; p0[4 * i + 3] *= x; x *= k0[4 * i + 3]; p0[4 * i + 2] *= x; x *= k0[4 * i + 2]; p0[4 * i + 1] *= x; x *= k0[4 * i + 1]; p0[4 * i] *= x; }
                { float x = xo[4 + i]; p1[4 * i + 3] *= x; x *= k1[4 * i + 3]; p1[4 * i + 2] *= x; x *= k1[4 * i + 2]; p1[4 * i + 1] *= x; x *= k1[4 * i + 1]; p1[4 * i] *= x; }
            }
            at_pv(o, p0, p1, vl, lane);
            if (__all(carry < 1e-30f)) break;
        }
        bf16* Ob = heads + ((size_t)b * SEQ + R0) * D + h * 64;
#pragma unroll
        for (int r = 0; r < 16; ++r) { const int q = crow(r, hi); Ob[(size_t)q * D + r32] = (bf16)f2bf(o[0][r]); Ob[(size_t)q * D + 32 + r32] = (bf16)f2bf(o[1][r]); }
    }
}

template <int KS> __device__ __forceinline__ void mma32(f32x16& acc, const LAS bf16* A, int lda, const LAS bf16* B, int ldb, int lane) {
    const int r = lane & 31, hh = lane >> 5;
#pragma unroll
    for (int ks = 0; ks < KS; ++ks) {
        const bf16x8 av = *(const LAS bf16x8*)(A + r * lda + ks * 16 + hh * 8);
        const bf16x8 bv = *(const LAS bf16x8*)(B + r * ldb + ks * 16 + hh * 8);
        acc = __builtin_amdgcn_mfma_f32_32x32x16_bf16(av, bv, acc, 0, 0, 0);
    }
}
constexpr int RK_CH = 32;
constexpr int RL_VZ = 0, RL_GG = 8192, RL_SC = 16384, RL_GP = 16896, RL_GL = 18944, RL_S0B = 19200, RL_MU = 28416, RL_LW = 30208;
constexpr int RL_RAW = 66048, RL_AT = 66048, RL_RT = 70656, RL_BT = 75264, RL_KT = 79872, RL_BTT = 84480, RL_KTT = 89600, RL_VT = 94720;
constexpr int RL_RZ = 99840, RL_KZ = 108032, RL_WL = 116224, RL_AL = 124416;
constexpr int RL_AAK = 99840, RL_ARB = 102400, RL_ARK = 104960, RL_LL = 107520, RL_XT = 110080, RL_UMT = 115200, RL_AAB = 120320;
constexpr int RL_LO = 132608, RL_OUT = 132608, RL_END = 149504;
constexpr int LO_LD = 264, LW_LD = 72, LG_LD = 136, T72 = 72, T40 = 40;
static_assert(RL_END <= LDS_BYTES - 64 && RL_AAB + 32 * 33 * 4 <= RL_LO && RL_RAW + 33 * 448 * 2 <= RL_RZ, "rwkv lds");
__device__ __forceinline__ void rwkv_phase(const Args& a, unsigned char* ws, LAS unsigned char* lds, int unit, unsigned sm) {
    int tid_l = threadIdx.x; asm volatile("" : "+v"(tid_l)); const int b = unit / NH, h = unit % NH, tid = tid_l, lane = tid & 63, wave = __builtin_amdgcn_readfirstlane(tid >> 6);
    const bf16* proj = (const bf16*)(ws + WS_HP) + (size_t)b * SEQ * RW_IN; bf16* heads = (bf16*)(ws + WS_HEADS) + (size_t)b * SEQ * D;
    LAS float* RZ = (LAS float*)(lds + RL_RZ); LAS float* KZ = (LAS float*)(lds + RL_KZ); LAS float* VZ = (LAS float*)(lds + RL_VZ);
    LAS float* WL = (LAS float*)(lds + RL_WL); LAS float* AL = (LAS float*)(lds + RL_AL); LAS float* GG = (LAS float*)(lds + RL_GG);
    LAS bf16* LO = (LAS bf16*)(lds + RL_LO); LAS float* SC = (LAS float*)(lds + RL_SC); LAS float* GP = (LAS float*)(lds + RL_GP); LAS float* GL = (LAS float*)(lds + RL_GL);
    LAS bf16* LWw = (LAS bf16*)(lds + RL_LW); LAS bf16* LWa = LWw + 64 * LW_LD; LAS bf16* LWg = LWa + 64 * LW_LD;
    LAS bf16* S0B = (LAS bf16*)(lds + RL_S0B); LAS float* MU = (LAS float*)(lds + RL_MU); LAS bf16* RAW = (LAS bf16*)(lds + RL_RAW);
    LAS bf16* AT = (LAS bf16*)(lds + RL_AT); LAS bf16* RT = (LAS bf16*)(lds + RL_RT); LAS bf16* BT = (LAS bf16*)(lds + RL_BT); LAS bf16* KT = (LAS bf16*)(lds + RL_KT);
    LAS bf16* BTT = (LAS bf16*)(lds + RL_BTT); LAS bf16* KTT = (LAS bf16*)(lds + RL_KTT); LAS bf16* VT = (LAS bf16*)(lds + RL_VT);
    LAS bf16* AAK = (LAS bf16*)(lds + RL_AAK); LAS bf16* ARB = (LAS bf16*)(lds + RL_ARB); LAS bf16* ARK = (LAS bf16*)(lds + RL_ARK); LAS bf16* LL = (LAS bf16*)(lds + RL_LL);
    LAS bf16* XT = (LAS bf16*)(lds + RL_XT); LAS bf16* UMT = (LAS bf16*)(lds + RL_UMT); LAS float* AAB = (LAS float*)(lds + RL_AAB); LAS float* OUT = (LAS float*)(lds + RL_OUT);
    { const bf16* gw_ = (const bf16*)(ws + WS_LW) + (size_t)h * 64 * 64; const bf16* ga_ = (const bf16*)(ws + WS_LW) + (size_t)768 * 64 + (size_t)h * 64 * 64;
      const bf16* gg_ = (const bf16*)(ws + WS_LW) + (size_t)768 * 128 + (size_t)h * 64 * 128;
      for (int i = tid; i < 64 * 64; i += NT) { const int n = i >> 6, k = i & 63; LWw[n * LW_LD + k] = gw_[i]; LWa[n * LW_LD + k] = ga_[i]; }
      for (int i = tid; i < 64 * 128; i += NT) { const int n = i >> 7, k = i & 127; LWg[n * LG_LD + k] = gg_[i]; } }
    for (int i = tid; i < 448; i += NT) MU[i] = a.mu[i < 192 ? (i >> 6) * C + h * 64 + (i & 63) : 3 * C + (i - 192)];
    for (int i = tid; i < 64 * T72 / 2; i += NT) ((LAS unsigned*)S0B)[i] = 0u;
    const int cl = lane, ch = h * 64 + cl;
    const float c_w0 = a.w0[ch], c_a0 = a.a0[ch], c_kk = a.k_k[ch], c_ka = a.k_a[ch], c_rk = a.r_k[ch], c_lg = a.lnx_g[ch], c_lb = a.lnx_b[ch];
    const int r32 = lane & 31, hi = lane >> 5;
    f32x16 Sreg = {0.f, 0.f, 0.f, 0.f, 0.f, 0.f, 0.f, 0.f, 0.f, 0.f, 0.f, 0.f, 0.f, 0.f, 0.f, 0.f};
    u32x4 raw[4];
    auto raw_load = [&](int t0) {
#pragma unroll
        for (int j = 0; j < 4; ++j) { const int i = tid + NT * j; const int row = i / 56, seg = i % 56, t = t0 - 1 + row;
            const int col = seg < 24 ? (seg >> 3) * C + h * 64 + (seg & 7) * 8 : 3 * C + (seg - 24) * 8;
            raw[j] = (u32x4){0u, 0u, 0u, 0u};
            if (i < 33 * 56 && t >= 0) raw[j] = *(const u32x4*)(proj + (size_t)t * RW_IN + col); } };
    auto raw_store = [&]() {
#pragma unroll
        for (int j = 0; j < 4; ++j) { const int i = tid + NT * j; if (i < 33 * 56) *(LAS u32x4*)(RAW + i * 8) = raw[j]; } };
    raw_load(0);
    __syncthreads();
    raw_store();
    __syncthreads();
    for (int t0 = 0; t0 < SEQ; t0 += RK_CH) {
#pragma unroll
        for (int j = 0; j < 4; ++j) {
            const int i = tid + NT * j;
            if ((sm & 2u) && i < RK_CH * 56) {
                const int tt = i / 56, sg = i % 56, cc0 = sg * 8;
                const bf16x8 cu = *(const LAS bf16x8*)(RAW + (tt + 1) * 448 + cc0), pv = *(const LAS bf16x8*)(RAW + tt * 448 + cc0);
                const f32x4 m0 = *(const LAS f32x4*)(MU + cc0), m1 = *(const LAS f32x4*)(MU + cc0 + 4);
                float z[8];
#pragma unroll
                for (int e = 0; e < 8; ++e) { const float cur = bf2f((unsigned short)cu[e]), prev = bf2f((unsigned short)pv[e]); z[e] = cur + (prev - cur) * (e < 4 ? m0[e] : m1[e - 4]); }
                if (sg < 24) {
                    LAS float* dst = (sg < 8 ? RZ : (sg < 16 ? KZ : VZ)) + tt * 64 + (cc0 & 63);
                    *(LAS f32x4*)dst = (f32x4){z[0], z[1], z[2], z[3]}; *(LAS f32x4*)(dst + 4) = (f32x4){z[4], z[5], z[6], z[7]};
                } else {
                    const int l0 = cc0 - 192;
                    const float sc = l0 < 64 ? -2.8853900817779268f : -1.4426950408889634f, ya = l0 < 64 ? 2.f : 1.f, yb = l0 < 64 ? -1.f : 0.f; const bool ident = (l0 >= 64) && (l0 < 128);
#pragma unroll
                    for (int e = 0; e < 8; ++e) { const float y = __builtin_amdgcn_rcpf(1.f + __builtin_amdgcn_exp2f(sc * z[e])) * ya + yb; z[e] = ident ? z[e] : y; }
                    *(LAS u32x4*)(LO + tt * LO_LD + l0) = (u32x4){pk2(z[0], z[1]), pk2(z[2], z[3]), pk2(z[4], z[5]), pk2(z[6], z[7])};
                }
            }
        }
        __syncthreads();
        if (t0 + RK_CH < SEQ) raw_load(t0 + RK_CH);
        if ((sm & 4u) && wave < 6) {
            const int mat = wave >> 1, nt = wave & 1;
            f32x16 acc = {0.f, 0.f, 0.f, 0.f, 0.f, 0.f, 0.f, 0.f, 0.f, 0.f, 0.f, 0.f, 0.f, 0.f, 0.f, 0.f};
            if (mat == 0) mma32<4>(acc, LO, LO_LD, LWw + nt * 32 * LW_LD, LW_LD, lane);
            else if (mat == 1) mma32<4>(acc, LO + 64, LO_LD, LWa + nt * 32 * LW_LD, LW_LD, lane);
            else mma32<8>(acc, LO + 128, LO_LD, LWg + nt * 32 * LG_LD, LG_LD, lane);
            LAS float* dst = mat == 0 ? WL : (mat == 1 ? AL : GG);
#pragma unroll
            for (int r = 0; r < 16; ++r) dst[crow(r, hi) * 64 + nt * 32 + r32] = acc[r];
        }
        __syncthreads();
        {
            float pw[4], pnk[4], pr[4], pk[4], pb[4], pvv[4]; float run = 1.f;
#pragma unroll
            for (int q = 0; q < 4; ++q) {
                if (!(sm & 8u)) break;
                const int tt = wave * 4 + q;
                const float wl = c_w0 + WL[tt * 64 + cl], al = c_a0 + AL[tt * 64 + cl];
                const float wlog = -(fmaxf(-wl, 0.f) + __logf(1.f + __expf(-fabsf(wl)))) - 0.5f, w = __expf(-__expf(wlog)), aa = __builtin_amdgcn_rcpf(1.f + __expf(-al));
                const float r = RZ[tt * 64 + cl], kraw = KZ[tt * 64 + cl];
                const float kkr = kraw * c_kk, ss = wave_sum(kkr * kkr), kkn = kkr * rsqrtf(fmaxf(ss, 1e-24f));
                const float k = kraw * (1.f + (aa - 1.f) * c_ka);
                const float bon = wave_sum(r * k * c_rk);
                if (lane == 0) SC[tt] = bon;
                run *= w; pw[q] = run; pnk[q] = -kkn; pr[q] = r; pk[q] = k; pb[q] = kkn * aa; pvv[q] = VZ[tt * 64 + cl];
            }
            GP[wave * 64 + cl] = run;
            __syncthreads();
            float E = 1.f;
#pragma unroll
            for (int g = 0; g < 7; ++g) { const float gp = GP[g * 64 + cl]; if (g < wave) E *= gp; }
            float gprev = E; unsigned bq[4], kq[4], vq[4];
#pragma unroll
            for (int q = 0; q < 4; ++q) {
                if (!(sm & 8u)) break;
                const int tt = wave * 4 + q; const float gm = E * pw[q], rg = __builtin_amdgcn_rcpf(gm);
                AT[tt * T72 + cl] = (bf16)f2bf(pnk[q] * gprev); RT[tt * T72 + cl] = (bf16)f2bf(pr[q] * gm);
                bq[q] = f2bf(pb[q] * rg); kq[q] = f2bf(pk[q] * rg); vq[q] = f2bf(pvv[q]);
                BT[tt * T72 + cl] = (bf16)bq[q]; KT[tt * T72 + cl] = (bf16)kq[q];
                gprev = gm;
            }
            *(LAS u32x2*)(BTT + cl * T40 + wave * 4) = (u32x2){bq[0] | (bq[1] << 16), bq[2] | (bq[3] << 16)};
            *(LAS u32x2*)(KTT + cl * T40 + wave * 4) = (u32x2){kq[0] | (kq[1] << 16), kq[2] | (kq[3] << 16)};
            *(LAS u32x2*)(VT + cl * T40 + wave * 4) = (u32x2){vq[0] | (vq[1] << 16), vq[2] | (vq[3] << 16)};
            if (wave == 7) GL[cl] = gprev;
        }
        __syncthreads();
        if ((sm & 16u) && wave < 4) {
            f32x16 acc = {0.f, 0.f, 0.f, 0.f, 0.f, 0.f, 0.f, 0.f, 0.f, 0.f, 0.f, 0.f, 0.f, 0.f, 0.f, 0.f};
            mma32<4>(acc, wave < 2 ? AT : RT, T72, (wave & 1) ? KT : BT, T72, lane);
#pragma unroll
            for (int r = 0; r < 16; ++r) { const int t = crow(r, hi); const bool keep = wave < 2 ? (r32 < t) : (r32 <= t); acc[r] = keep ? acc[r] : 0.f; }
            if (wave != 0) {
#pragma unroll
                for (int r = 0; r < 16; ++r) (wave == 1 ? AAK : (wave == 2 ? ARB : ARK))[crow(r, hi) * T40 + r32] = (bf16)f2bf(acc[r]);
            } else {
                LAS bf16* PA = (LAS bf16*)AAB;
                f32x16 Lc = acc, Pc = acc;
#pragma unroll
                for (int r = 0; r < 16; ++r) { Lc[r] += (crow(r, hi) == r32) ? 1.f : 0.f; PA[crow(r, hi) * T40 + r32] = (bf16)f2bf(acc[r]); }
                const LAS bf16* pa = PA + r32 * T40 + 4 * hi;
#pragma unroll 1
                for (int k = 0; k < 4; ++k) {
                    bf16x8 af0, af1, bf0, bf1;
                    { const u32x2 a0 = *(const LAS u32x2*)(pa), a1 = *(const LAS u32x2*)(pa + 8), a2 = *(const LAS u32x2*)(pa + 16), a3 = *(const LAS u32x2*)(pa + 24);
                      af0 = __builtin_bit_cast(bf16x8, (u32x4){a0[0], a0[1], a1[0], a1[1]}); af1 = __builtin_bit_cast(bf16x8, (u32x4){a2[0], a2[1], a3[0], a3[1]}); }
                    bf0 = __builtin_bit_cast(bf16x8, (u32x4){cvtpk(Pc[0], Pc[1]), cvtpk(Pc[2], Pc[3]), cvtpk(Pc[4], Pc[5]), cvtpk(Pc[6], Pc[7])});
                    bf1 = __builtin_bit_cast(bf16x8, (u32x4){cvtpk(Pc[8], Pc[9]), cvtpk(Pc[10], Pc[11]), cvtpk(Pc[12], Pc[13]), cvtpk(Pc[14], Pc[15])});
                    f32x16 Pn = {0.f, 0.f, 0.f, 0.f, 0.f, 0.f, 0.f, 0.f, 0.f, 0.f, 0.f, 0.f, 0.f, 0.f, 0.f, 0.f};
                    Pn = __builtin_amdgcn_mfma_f32_32x32x16_bf16(af0, bf0, Pn, 0, 0, 0); Pn = __builtin_amdgcn_mfma_f32_32x32x16_bf16(af1, bf1, Pn, 0, 0, 0);
#pragma unroll
                    for (int r = 0; r < 16; ++r) PA[crow(r, hi) * T40 + r32] = (bf16)f2bf(Pn[r]);
                    { const u32x2 a0 = *(const LAS u32x2*)(pa), a1 = *(const LAS u32x2*)(pa + 8), a2 = *(const LAS u32x2*)(pa + 16), a3 = *(const LAS u32x2*)(pa + 24);
                      af0 = __builtin_bit_cast(bf16x8, (u32x4){a0[0], a0[1], a1[0], a1[1]}); af1 = __builtin_bit_cast(bf16x8, (u32x4){a2[0], a2[1], a3[0], a3[1]}); }
                    bf0 = __builtin_bit_cast(bf16x8, (u32x4){cvtpk(Lc[0], Lc[1]), cvtpk(Lc[2], Lc[3]), cvtpk(Lc[4], Lc[5]), cvtpk(Lc[6], Lc[7])});
                    bf1 = __builtin_bit_cast(bf16x8, (u32x4){cvtpk(Lc[8], Lc[9]), cvtpk(Lc[10], Lc[11]), cvtpk(Lc[12], Lc[13]), cvtpk(Lc[14], Lc[15])});
                    Lc = __builtin_amdgcn_mfma_f32_32x32x16_bf16(af0, bf0, Lc, 0, 0, 0); Lc = __builtin_amdgcn_mfma_f32_32x32x16_bf16(af1, bf1, Lc, 0, 0, 0);
                    Pc = Pn;
                }
#pragma unroll
                for (int r = 0; r < 16; ++r) LL[crow(r, hi) * T40 + r32] = (bf16)f2bf(Lc[r]);
            }
        }
        __syncthreads();
        if ((sm & 64u) && wave < 2) {
            const int ih = wave; const f32x16 zz = {0.f, 0.f, 0.f, 0.f, 0.f, 0.f, 0.f, 0.f, 0.f, 0.f, 0.f, 0.f, 0.f, 0.f, 0.f, 0.f};
            f32x16 x = zz;
            mma32<4>(x, AT, T72, S0B + ih * 32 * T72, T72, lane);
            mma32<2>(x, AAK, T40, VT + ih * 32 * T40, T40, lane);
#pragma unroll
            for (int g = 0; g < 4; ++g) *(LAS u32x2*)(XT + (ih * 32 + r32) * T40 + 8 * g + 4 * hi) = (u32x2){pk2(x[4 * g], x[4 * g + 1]), pk2(x[4 * g + 2], x[4 * g + 3])};
            f32x16 um = zz;
            mma32<2>(um, LL, T40, XT + ih * 32 * T40, T40, lane);
#pragma unroll
            for (int g = 0; g < 4; ++g) *(LAS u32x2*)(UMT + (ih * 32 + r32) * T40 + 8 * g + 4 * hi) = (u32x2){pk2(um[4 * g], um[4 * g + 1]), pk2(um[4 * g + 2], um[4 * g + 3])};
            f32x16 o = zz;
            mma32<4>(o, RT, T72, S0B + ih * 32 * T72, T72, lane);
            mma32<2>(o, ARB, T40, UMT + ih * 32 * T40, T40, lane);
            mma32<2>(o, ARK, T40, VT + ih * 32 * T40, T40, lane);
#pragma unroll
            for (int r = 0; r < 16; ++r) OUT[crow(r, hi) * 64 + ih * 32 + r32] = o[r];
        }
        __syncthreads();
        if ((sm & 128u) && wave < 4) {
            const int jt = wave >> 1, it = wave & 1;
            mma32<2>(Sreg, BTT + jt * 32 * T40, T40, UMT + it * 32 * T40, T40, lane);
            mma32<2>(Sreg, KTT + jt * 32 * T40, T40, VT + it * 32 * T40, T40, lane);
#pragma unroll
            for (int g = 0; g < 4; ++g) { const f32x4 gl = *(const LAS f32x4*)(GL + jt * 32 + 8 * g + 4 * hi);
                Sreg[4 * g] *= gl[0]; Sreg[4 * g + 1] *= gl[1]; Sreg[4 * g + 2] *= gl[2]; Sreg[4 * g + 3] *= gl[3];
                *(LAS u32x2*)(S0B + (it * 32 + r32) * T72 + jt * 32 + 8 * g + 4 * hi) = (u32x2){pk2(Sreg[4 * g], Sreg[4 * g + 1]), pk2(Sreg[4 * g + 2], Sreg[4 * g + 3])}; }
        }
        __syncthreads();
        raw_store();
#pragma unroll 2
        for (int q = 0; q < 4; ++q) {
            if (!(sm & 256u)) break;
            const int tt = wave * 4 + q;
            const float o = OUT[tt * 64 + cl];
            const float m = wave_sum(o) * (1.f / 64.f), d = o - m, var = wave_sum(d * d) * (1.f / 64.f);
            const float y = d * rsqrtf(var + LNX_EPS) * c_lg + c_lb;
            const float res = (y + SC[tt] * VZ[tt * 64 + cl]) * GG[tt * 64 + cl];
            heads[(size_t)(t0 + tt) * D + ch] = (bf16)f2bf(res);
        }
        __syncthreads();
    }
}

#define GAS __attribute__((address_space(1)))
typedef GAS unsigned gu32;
#define XB_TMO      128
#define XB_XCNT(j)  (256  + 64 * (j))
#define XB_XSUB(j)  (1280 + 64 * (j))
#define XB_XGEN(j)  (2304 + 64 * (j))
#define XB_TOP      3328
#define XB_TOPGEN   3392
#define XCD_BAR_WORDS 3456
#define XB_SPIN_CAP (1u << 18)

__device__ __forceinline__ unsigned xb_ld(unsigned* p)              { return __hip_atomic_load(p, __ATOMIC_RELAXED, __HIP_MEMORY_SCOPE_AGENT); }
__device__ __forceinline__ unsigned xb_add(unsigned* p, unsigned v) { return __hip_atomic_fetch_add(p, v, __ATOMIC_RELAXED, __HIP_MEMORY_SCOPE_AGENT); }
__device__ __forceinline__ unsigned xb_xcc_id() { return (unsigned)__builtin_amdgcn_s_getreg((3 << 11) | 20) & 0xFu; }
#define XB_SPIN(cond, bar) do { unsigned _sp = 0; while (cond) { __builtin_amdgcn_s_sleep(1); \
    if ((++_sp & 255u) == 0u) { if (xb_ld(&(bar)[XB_TMO])) break; if (_sp > XB_SPIN_CAP) { atomicAdd(&(bar)[XB_TMO], 1u); break; } } } } while (0)

struct XcdBarrier {
    unsigned* bar; unsigned x;
    volatile LAS unsigned* st;
};

__device__ __forceinline__ XcdBarrier xcd_barrier_post(unsigned* bar, volatile LAS unsigned* st) {
    XcdBarrier b; b.bar = bar; b.x = xb_xcc_id(); b.st = st;
    if (threadIdx.x == 0) (void)xb_add(&bar[XB_XCNT(b.x)], 1u);
    return b;
}
__device__ __forceinline__ void xcd_barrier_complete(unsigned* bar, unsigned x, unsigned& nloc, unsigned& nx) {
    const unsigned G = gridDim.x * gridDim.y * gridDim.z;
    unsigned sum, cnt, mine, sp = 0u;
    for (;;) {
        sum = 0u; cnt = 0u; mine = 0u;
#pragma unroll
        for (unsigned j = 0; j < 16; ++j) { const unsigned c = xb_ld(&bar[XB_XCNT(j)]); sum += c; cnt += (c > 0u) ? 1u : 0u; mine = (j == x) ? c : mine; }
        if (sum == G) break;
        __builtin_amdgcn_s_sleep(1);
        if ((++sp & 255u) == 0u) { if (xb_ld(&bar[XB_TMO])) break; if (sp > XB_SPIN_CAP) { atomicAdd(&bar[XB_TMO], 1u); break; } }
    }
    nloc = mine > 0u ? mine : 1u; nx = cnt > 0u ? cnt : 1u;
}

__device__ __forceinline__ void xcd_barrier(const XcdBarrier& b) {
    asm volatile("s_waitcnt vmcnt(0)" ::: "memory");
    __syncthreads();
    if (threadIdx.x == 0) {
        unsigned* bar = b.bar;
        __builtin_amdgcn_s_waitcnt(0);
        unsigned nloc = b.st[0], nx = b.st[1];
        if (nloc == 0u) { xcd_barrier_complete(bar, b.x, nloc, nx); b.st[0] = nloc; b.st[1] = nx; }
        const unsigned old = xb_add(&bar[XB_XSUB(b.x)], 1u);
        const unsigned gen = old / nloc;
        if (old + 1u == (gen + 1u) * nloc) {
            __builtin_amdgcn_fence(__ATOMIC_RELEASE, "agent");
            asm volatile("s_waitcnt vmcnt(0)" ::: "memory");
            const unsigned og = xb_add(&bar[XB_TOP], 1u);
            const unsigned tg = og / nx;
            if (og + 1u == (tg + 1u) * nx) xb_add(&bar[XB_TOPGEN], 1u);
            else XB_SPIN(xb_ld(&bar[XB_TOPGEN]) == tg, bar);
            __builtin_amdgcn_fence(__ATOMIC_ACQUIRE, "agent");
            xb_add(&bar[XB_XGEN(b.x)], 1u);
            asm volatile("s_waitcnt vmcnt(0)" ::: "memory");
        } else {
            XB_SPIN(xb_ld(&bar[XB_XGEN(b.x)]) == gen, bar);
            __builtin_amdgcn_fence(__ATOMIC_ACQUIRE, "agent");
            asm volatile("s_waitcnt vmcnt(0)" ::: "memory");
        }
    }
    __syncthreads();
}

#ifndef MK_DUP
#define MK_DUP -1
#endif
#ifndef MK_DBG
#define MK_DBG 0x1ff
#endif
constexpr int NPHASES = 1 + 2 * (3 + 4 + 3);
__global__ void __launch_bounds__(NT, 2) mega(Args a) {
    extern __shared__ __attribute__((aligned(16))) unsigned char lds_raw[];
    LAS unsigned char* lds = (LAS unsigned char*)lds_raw;
    cg::grid_group grid = cg::this_grid();
    volatile LAS unsigned* bst = (volatile LAS unsigned*)(lds + LDS_BYTES - 64);
    if (threadIdx.x == 0) { bst[0] = 0u; bst[1] = 0u; }
    __syncthreads();
    XcdBarrier bar = xcd_barrier_post(a.barw, bst);
#pragma unroll 1
    for (int ph = 0; ph < NPHASES; ph = __builtin_amdgcn_readfirstlane(ph + 1)) {
#if MK_DUP >= 0
        const int nrep = (ph == MK_DUP) ? 2 : 1;
#pragma unroll 1
        for (int rep0 = 0; rep0 < nrep; rep0 = __builtin_amdgcn_readfirstlane(rep0 + 1)) {
        int repv = rep0; asm volatile("" : "+s"(repv)); const bool neutral = repv + 1 < nrep;
#else
        {
        const bool neutral = false;
#endif
        int p = ph; asm volatile("" : "+s"(p));
        unsigned char* ws = a.ws; asm volatile("" : "+s"(ws));
        int tid_l = threadIdx.x; asm volatile("" : "+v"(tid_l));
        const int tid = tid_l, lane = tid & 63, wave = __builtin_amdgcn_readfirstlane(tid >> 6);
        const int G = gridDim.x, wg = blockIdx.x, gw = wg * NWAVES + wave, ngw = G * NWAVES;
        bf16* xb = (bf16*)(ws + WS_XB); bf16* hp = (bf16*)(ws + WS_HP); bf16* heads = (bf16*)(ws + WS_HEADS);
        const int L = p > 10 ? 1 : 0, sub = p == 0 ? 10 : (p - 1) - 10 * L;
        switch (sub) {
        case 10: p0_prologue(a, lds, gw, ngw, wave, lane); __syncthreads(); break;
        case 0: case 7: {
            const int fi = L * 2 + (sub == 7 ? 1 : 0);
            pg8::Gemm g{xb, (const bf16*)(ws + WS_WGU) + (size_t)fi * 2 * FF * D, M, 2 * FF, D}; pg8::StaticOrder S; S.init(M, 2 * FF, G, wg);
            pg8::EpiSwiglu E{hp, FF};
            pg8::gemm_phase<pg8::EpiSwiglu, pg8::StaticOrder, true, true>(lds, g, S, E); } break;
        case 1: case 8: {
            const int fi = L * 2 + (sub == 8 ? 1 : 0);
            pg8::Gemm g{hp, (const bf16*)(ws + WS_WD) + (size_t)fi * FF * D, M, D, FF}; pg8::StaticOrder S; S.init(M, D, G, wg);
            pg8::EpiRes E{a.out, neutral ? 1.0f : ALPHA, neutral ? 0.0f : 0.5f};
            pg8::gemm_phase<pg8::EpiRes, pg8::StaticOrder, true, true>(lds, g, S, E); } break;
        case 5: {
            pg8::Gemm g{heads, (const bf16*)(ws + WS_WOUT) + (size_t)L * D * D, M, D, D}; pg8::StaticOrder S; S.init(M, D, G, wg);
            pg8::EpiRes E{a.out, neutral ? 1.0f : ALPHA, neutral ? 0.0f : 1.0f};
            pg8::gemm_phase<pg8::EpiRes, pg8::StaticOrder, true, true>(lds, g, S, E); } break;
        case 2: case 6: case 9:
            ln_phase(a, ws, L * 3 + (sub == 2 ? 0 : (sub == 6 ? 1 : 2)), gw, ngw, lane, neutral); break;
        case 3: {
            const int nrp = L == 0 ? 2 : 1;
#pragma unroll 1
            for (int rep = 0; rep < nrp; rep = __builtin_amdgcn_readfirstlane(rep + 1)) {
                int rp = rep; asm volatile("" : "+s"(rp));
                const int N = rp == 1 ? 512 : (L == 0 ? RW_IN : SB_IN), Mr = rp == 1 ? NB * NMEM : M;
                pg8::Gemm g{rp == 1 ? (const bf16*)(ws + WS_MEMB) : xb, (const bf16*)(ws + (rp == 1 ? WS_WMKV : (L == 0 ? WS_WIN0 : WS_WIN1))), Mr, N, D}; pg8::StaticOrder S; S.init(Mr, N, G, wg);
                pg8::EpiBf16<0> E{rp == 1 ? (bf16*)(ws + WS_MEMKV) : hp, N, nullptr, 0, 0, 1.f};
                pg8::gemm_phase<pg8::EpiBf16<0>, pg8::StaticOrder, true, true>(lds, g, S, E);
            } } break;
        default:
            if (L == 0) {
                const unsigned sm = neutral ? (unsigned)MK_DBG : 0xffffffffu;
                if (wg < NB * NH) rwkv_phase(a, ws, lds, wg, sm);
                else if (sm & 1u) memattn_phase(ws, lds, RW_IN, RW_SHIFT, (wg - NB * NH) * NWAVES + wave, (G - NB * NH) * NWAVES);
            } else {
                sb_phase(ws, lds, gw, ngw);
                memattn_phase(ws, lds, SB_IN, 3 * C, gw, ngw);
            }
            break;
        }
        }
        if (ph + 1 < NPHASES) { if (ph == 0) grid.sync(); else xcd_barrier(bar); }
    }
}


extern "C" void kernel_launch(void* const* d_in, const int* in_sizes, int n_in, void* d_out, int out_size, void* d_ws, size_t ws_size, hipStream_t stream) {
    static int grid = 0;
    if (grid == 0) {
        if (n_in != 25 || out_size != M * D || ws_size < WS_END) { fprintf(stderr, "kernel_launch: unexpected shapes (n_in %d out %d ws %zu)\n", n_in, out_size, ws_size); grid = -1; return; }
        int dev = 0, cus = 0, per_cu = 0;
        (void)hipGetDevice(&dev); (void)hipDeviceGetAttribute(&cus, hipDeviceAttributeMultiprocessorCount, dev);
        if (hipFuncSetAttribute((const void*)mega, hipFuncAttributeMaxDynamicSharedMemorySize, LDS_BYTES) != hipSuccess) { fprintf(stderr, "kernel_launch: hipFuncSetAttribute failed\n"); grid = -1; return; }
        if (hipOccupancyMaxActiveBlocksPerMultiprocessor(&per_cu, (const void*)mega, NT, LDS_BYTES) != hipSuccess || per_cu < 1) { fprintf(stderr, "kernel_launch: occupancy query failed (%d)\n", per_cu); per_cu = 1; }
        (void)hipGetLastError();
        grid = cus;
        fprintf(stderr, "kernel_launch: cus %d per_cu %d grid %d\n", cus, per_cu, grid);
    }
    if (grid < 0) return;
    Args a{};
    const float* const* in = (const float* const*)d_in;
    a.x = in[0]; a.mem = in[1]; a.ln_g = in[8]; a.ln_b = in[9];
    a.mu = in[13]; a.w0 = in[14]; a.a0 = in[16]; a.k_k = in[19]; a.k_a = in[20]; a.r_k = in[21]; a.lnx_g = in[22]; a.lnx_b = in[23];
    a.out = (float*)d_out; a.ws = (unsigned char*)d_ws; a.barw = (unsigned*)d_ws;
    unsigned char* ws = (unsigned char*)d_ws;
    int nd = 0, first = 0;
    auto add = [&](const float* src, bf16* dst, int K, int N, int mode) { a.td[nd] = TDesc{src, dst, K, N, mode, first}; first += (K / 64) * (N / 32); ++nd; };
    for (int layer = 0; layer < 2; ++layer)
        for (int f = 0; f < 2; ++f) {
            const int fi = layer * 2 + f; bf16* gu = (bf16*)(ws + WS_WGU) + (size_t)fi * 2 * FF * D;
            add(in[f == 0 ? 2 : 5] + (size_t)layer * D * FF, gu, D, FF, 1);
            add(in[f == 0 ? 3 : 6] + (size_t)layer * D * FF, gu, D, FF, 2);
            add(in[f == 0 ? 4 : 7] + (size_t)layer * FF * D, (bf16*)(ws + WS_WD) + (size_t)fi * FF * D, FF, D, 0);
        }
    add(in[12], (bf16*)(ws + WS_WIN0), D, RW_IN, 0);
    add(in[24], (bf16*)(ws + WS_WIN1), D, SB_IN, 0);
    add(in[10], (bf16*)(ws + WS_WOUT), D, D, 0);
    add(in[10] + (size_t)D * D, (bf16*)(ws + WS_WOUT) + (size_t)D * D, D, D, 0);
    add(in[11], (bf16*)(ws + WS_WMKV), D, 512, 0);
    add(in[15], (bf16*)(ws + WS_LW), 64, C, 0);
    add(in[17], (bf16*)(ws + WS_LW) + (size_t)768 * 64, 64, C, 0);
    add(in[18], (bf16*)(ws + WS_LW) + (size_t)768 * 128, 128, C, 0);
    for (; nd < NDESC; ++nd) a.td[nd] = TDesc{nullptr, nullptr, 64, 32, 0, 0x7fffffff};
    a.nitems = first;
    if (hipMemsetAsync(d_ws, 0, 16384, stream) != hipSuccess) { fprintf(stderr, "kernel_launch: memset failed\n"); return; }
    void* args[] = {&a};
    hipError_t e = hipLaunchCooperativeKernel((const void*)mega, dim3(grid), dim3(NT), args, LDS_BYTES, stream);
    if (e != hipSuccess) fprintf(stderr, "cooperative launch failed: %s (grid %d)\n", hipGetErrorString(e), grid);
}
```
